# Optimizing an MI355X kernel written in HIP

```python
import math
import jax, jax.numpy as jnp
from jax import lax
import numpy as np

D_MODEL = 1024
BATCH = 8
SEQ = 4096
DEPTH = 1

CHUNK = 64
MEM_TOKENS = 256

SSM_WIDTH = D_MODEL // 2
SSM_GROUP_CH = 16
SSM_GROUPS = SSM_WIDTH // SSM_GROUP_CH
SSM_STATE = 64
FOX_WIDTH = D_MODEL - SSM_WIDTH
FOX_HEAD_DIM = 64
FOX_HEADS = FOX_WIDTH // FOX_HEAD_DIM
Q_BLOCK = 128
IN_PROJ_COLS = SSM_WIDTH + 3 * FOX_WIDTH + FOX_HEADS

XA_HEADS = 4
XA_HEAD_DIM = D_MODEL // XA_HEADS

FFN_HIDDEN = int(math.ceil(8 * D_MODEL / 3 / 256) * 256)

RMS_EPS = 1e-6
NEG_INF = -1e30
DT_MIN = 1e-3
DT_MAX = 1e-1

kernel_name = "hybrid_s5_fox_memxattn_block"


def rms_norm(x, g):
    xf = x.astype(jnp.float32)
    y = xf * lax.rsqrt(jnp.mean(xf * xf, axis=-1, keepdims=True) + RMS_EPS)
    return (y * g.astype(jnp.float32)).astype(x.dtype)


def s5_mixer(u, a_re, a_im, log_dt, b_re, b_im, c_re, c_im, d_skip, glu_w, glu_b):
    bsz, seq, _ = u.shape
    uf = u.astype(jnp.float32).reshape(bsz, seq, SSM_GROUPS, SSM_GROUP_CH)
    a = lax.complex(a_re.astype(jnp.float32), a_im.astype(jnp.float32))
    dt = jnp.exp(log_dt.astype(jnp.float32))[:, None]
    a_bar = jnp.exp(a * dt)
    b = lax.complex(b_re.astype(jnp.float32), b_im.astype(jnp.float32))
    b_bar = ((a_bar - 1.0) / a)[..., None] * b
    bu = jnp.einsum('bsgi,gni->bsgn', uf.astype(jnp.complex64), b_bar)
    a_seq = jnp.broadcast_to(a_bar, bu.shape)

    def combine(left, right):
        a_l, x_l = left
        a_r, x_r = right
        return a_l * a_r, a_r * x_l + x_r

    _, states = lax.associative_scan(combine, (a_seq, bu), axis=1)
    c = lax.complex(c_re.astype(jnp.float32), c_im.astype(jnp.float32))
    y = jnp.real(jnp.einsum('bsgn,gin->bsgi', states, c))
    y = y + d_skip.astype(jnp.float32).reshape(SSM_GROUPS, SSM_GROUP_CH) * uf
    y = y.reshape(bsz, seq, SSM_WIDTH)
    g = jax.nn.gelu(y)
    out = g * jax.nn.sigmoid(g @ glu_w.astype(jnp.float32) + glu_b.astype(jnp.float32))
    return out.astype(u.dtype)


def forgetting_attention(q, k, v, f_logit):
    bsz, seq, heads, hd = q.shape
    scale = 1.0 / math.sqrt(hd)
    cum_log_f = jnp.cumsum(jax.nn.log_sigmoid(f_logit.astype(jnp.float32)), axis=1)
    cum_log_f = jnp.transpose(cum_log_f, (0, 2, 1))
    outs = []
    for blk in range(seq // Q_BLOCK):
        q0 = blk * Q_BLOCK
        k_end = q0 + Q_BLOCK
        qb = q[:, q0:k_end]
        kb = k[:, :k_end]
        vb = v[:, :k_end]
        s = jnp.einsum('bqhd,bkhd->bhqk', qb, kb).astype(jnp.float32) * scale
        bias = cum_log_f[:, :, q0:k_end, None] - cum_log_f[:, :, None, :k_end]
        q_pos = q0 + jnp.arange(Q_BLOCK)
        k_pos = jnp.arange(k_end)
        mask = q_pos[:, None] >= k_pos[None, :]
        s = jnp.where(mask, s + bias, NEG_INF)
        p = jax.nn.softmax(s, axis=-1)
        outs.append(jnp.einsum('bhqk,bkhd->bqhd', p.astype(v.dtype), vb))
    return jnp.concatenate(outs, axis=1)


def memory_cross_attention(h, mem_n, wq, wkv, wo):
    bsz, seq, _ = h.shape
    m = mem_n.shape[1]
    q = (h @ wq).reshape(bsz, seq, XA_HEADS, XA_HEAD_DIM)
    kv = mem_n @ wkv
    k = kv[..., :D_MODEL].reshape(bsz, m, XA_HEADS, XA_HEAD_DIM)
    v = kv[..., D_MODEL:].reshape(bsz, m, XA_HEADS, XA_HEAD_DIM)
    s = jnp.einsum('bqhd,bmhd->bhqm', q, k).astype(jnp.float32) / math.sqrt(XA_HEAD_DIM)
    p = jax.nn.softmax(s, axis=-1)
    o = jnp.einsum('bhqm,bmhd->bqhd', p.astype(v.dtype), v).reshape(bsz, seq, D_MODEL)
    return o @ wo


def swiglu(h, w_gate, w_up, w_down):
    return (jax.nn.silu(h @ w_gate) * (h @ w_up)) @ w_down


def setup_inputs(seed: int = 0) -> dict:
    key = jax.random.key(seed)
    ks = jax.random.split(key, 40)
    f32 = jnp.float32

    def dense(k, fan_in, shape):
        return jax.random.normal(k, shape, f32) * fan_in ** -0.5

    def gain(k, n):
        return jnp.ones((n,), f32) + 0.02 * jax.random.normal(k, (n,), f32)

    n_idx = jnp.arange(SSM_STATE, dtype=f32)
    a_re = -0.5 + 0.01 * jax.random.normal(ks[4], (SSM_GROUPS, SSM_STATE), f32)
    a_im = math.pi * n_idx[None, :] + 0.01 * jax.random.normal(ks[5], (SSM_GROUPS, SSM_STATE), f32)
    log_dt = jax.random.uniform(ks[6], (SSM_GROUPS,), f32, math.log(DT_MIN), math.log(DT_MAX))
    b_scale = (2.0 * SSM_GROUP_CH) ** -0.5
    c_scale = (2.0 * SSM_STATE) ** -0.5
    return {
        "x": jax.random.normal(ks[0], (BATCH, SEQ, D_MODEL), f32),
        "mem": jax.random.normal(ks[1], (BATCH, MEM_TOKENS, D_MODEL), f32),
        "mix_pre_g": gain(ks[2], D_MODEL),
        "w_in": dense(ks[3], D_MODEL, (D_MODEL, IN_PROJ_COLS)),
        "ssm_a_re": a_re,
        "ssm_a_im": a_im,
        "ssm_log_dt": log_dt,
        "ssm_b_re": jax.random.normal(ks[7], (SSM_GROUPS, SSM_STATE, SSM_GROUP_CH), f32) * b_scale,
        "ssm_b_im": jax.random.normal(ks[8], (SSM_GROUPS, SSM_STATE, SSM_GROUP_CH), f32) * b_scale,
        "ssm_c_re": jax.random.normal(ks[9], (SSM_GROUPS, SSM_GROUP_CH, SSM_STATE), f32) * c_scale,
        "ssm_c_im": jax.random.normal(ks[10], (SSM_GROUPS, SSM_GROUP_CH, SSM_STATE), f32) * c_scale,
        "ssm_d": jax.random.normal(ks[11], (SSM_WIDTH,), f32),
        "ssm_glu_w": dense(ks[12], SSM_WIDTH, (SSM_WIDTH, SSM_WIDTH)),
        "ssm_glu_b": 0.01 * jax.random.normal(ks[13], (SSM_WIDTH,), f32),
        "fox_f_bias": jax.random.uniform(ks[14], (FOX_HEADS,), f32, 1.0, 4.0),
        "ssm_out_g": gain(ks[15], SSM_WIDTH),
        "fox_out_g": gain(ks[16], FOX_WIDTH),
        "w_out": dense(ks[17], D_MODEL, (D_MODEL, D_MODEL)),
        "mix_post_g": gain(ks[18], D_MODEL),
        "xa_pre_g": gain(ks[19], D_MODEL),
        "mem_g": gain(ks[20], D_MODEL),
        "xa_wq": dense(ks[21], D_MODEL, (D_MODEL, D_MODEL)),
        "xa_wkv": dense(ks[22], D_MODEL, (D_MODEL, 2 * D_MODEL)),
        "xa_wo": dense(ks[23], D_MODEL, (D_MODEL, D_MODEL)),
        "xa_post_g": gain(ks[24], D_MODEL),
        "ffn_pre_g": gain(ks[25], D_MODEL),
        "w_gate": dense(ks[26], D_MODEL, (D_MODEL, FFN_HIDDEN)),
        "w_up": dense(ks[27], D_MODEL, (D_MODEL, FFN_HIDDEN)),
        "w_down": dense(ks[28], FFN_HIDDEN, (FFN_HIDDEN, D_MODEL)),
        "ffn_post_g": gain(ks[29], D_MODEL),
    }


def reference(x, mem, mix_pre_g, w_in, ssm_a_re, ssm_a_im, ssm_log_dt, ssm_b_re, ssm_b_im,
              ssm_c_re, ssm_c_im, ssm_d, ssm_glu_w, ssm_glu_b, fox_f_bias, ssm_out_g, fox_out_g,
              w_out, mix_post_g, xa_pre_g, mem_g, xa_wq, xa_wkv, xa_wo, xa_post_g,
              ffn_pre_g, w_gate, w_up, w_down, ffn_post_g):
    bsz, seq, _ = x.shape
    mem_n = rms_norm(mem, mem_g)
    for _layer in range(DEPTH):
        h = rms_norm(x, mix_pre_g)
        proj = h @ w_in
        o0 = SSM_WIDTH
        u = proj[..., :o0]
        q = proj[..., o0:o0 + FOX_WIDTH].reshape(bsz, seq, FOX_HEADS, FOX_HEAD_DIM)
        k = proj[..., o0 + FOX_WIDTH:o0 + 2 * FOX_WIDTH].reshape(bsz, seq, FOX_HEADS, FOX_HEAD_DIM)
        v = proj[..., o0 + 2 * FOX_WIDTH:o0 + 3 * FOX_WIDTH].reshape(bsz, seq, FOX_HEADS, FOX_HEAD_DIM)
        f_logit = proj[..., o0 + 3 * FOX_WIDTH:] + fox_f_bias

        y_ssm = s5_mixer(u, ssm_a_re, ssm_a_im, ssm_log_dt, ssm_b_re, ssm_b_im,
                         ssm_c_re, ssm_c_im, ssm_d, ssm_glu_w, ssm_glu_b)
        y_fox = forgetting_attention(q, k, v, f_logit).reshape(bsz, seq, FOX_WIDTH)
        y_mix = jnp.concatenate([rms_norm(y_ssm, ssm_out_g), rms_norm(y_fox, fox_out_g)], axis=-1)
        x = x + rms_norm(y_mix @ w_out, mix_post_g)

        h = rms_norm(x, xa_pre_g)
        x = x + rms_norm(memory_cross_attention(h, mem_n, xa_wq, xa_wkv, xa_wo), xa_post_g)

        h = rms_norm(x, ffn_pre_g)
        x = x + rms_norm(swiglu(h, w_gate, w_up, w_down), ffn_post_g)
    return x
```

```cpp
#include <hip/hip_runtime.h>
#include <hip/hip_cooperative_groups.h>
#include <hip/hip_bf16.h>
#include <cstdio>
#include <cstdint>
#include <cmath>
namespace cg = cooperative_groups;

#ifndef MK_COOP
#define MK_COOP 1
#endif

#define LAS __attribute__((address_space(3)))
#define GAS __attribute__((address_space(1)))

namespace pg8 {
typedef unsigned short bf16_t;
typedef short bf16x8 __attribute__((ext_vector_type(8)));
typedef float f32x4 __attribute__((ext_vector_type(4)));
typedef float f32x2 __attribute__((ext_vector_type(2)));
typedef unsigned u32x4 __attribute__((ext_vector_type(4)));
typedef unsigned u32x2 __attribute__((ext_vector_type(2)));
constexpr int BM = 256, BK = 64, HALF = 128, HTB = HALF * BK * 2, STAGE_BYTES = 8 * HTB, NXCD = 8, WGM = 8;

__host__ __device__ __forceinline__ int lds_byte(int r, int c) { const int st = (r >> 4) * 2 + (c >> 5), rr = r & 15, cc = c & 31, ob = rr * 64 + cc * 2; return st * 1024 + (ob ^ (((ob >> 9) & 1) << 5)); }
__host__ __device__ __forceinline__ void stage_rc(int b, int& R, int& C) { const int st = b / 1024, sb = b % 1024, swz = sb ^ (((sb >> 9) & 1) << 5); R = (st >> 1) * 16 + swz / 64; C = (st & 1) * 32 + (swz % 64) / 2; }
__host__ __device__ __forceinline__ int perm32(int rho) { const int n = rho >> 4, i = rho & 15; return 8 * (i >> 2) + 4 * n + (i & 3); }

struct Unit { int pm, pn, z; const char* a; const char* b; };
struct Gemm { int lda, ldb, K; };

__device__ __forceinline__ unsigned cvt_pk_bf16(float lo, float hi) { unsigned r; asm volatile("v_cvt_pk_bf16_f32 %0, %1, %2" : "=v"(r) : "v"(lo), "v"(hi)); return r; }
__device__ __forceinline__ void store8(bf16_t* p, f32x4 v0, f32x4 v1) { u32x4 w; w.x = cvt_pk_bf16(v0[0], v0[1]); w.y = cvt_pk_bf16(v0[2], v0[3]); w.z = cvt_pk_bf16(v1[0], v1[1]); w.w = cvt_pk_bf16(v1[2], v1[3]); *(u32x4*)p = w; }
__device__ __forceinline__ float bf_lo(unsigned w) { return __uint_as_float(w << 16); }
__device__ __forceinline__ float bf_hi(unsigned w) { return __uint_as_float(w & 0xffff0000u); }
__device__ __forceinline__ float fsigmoid(float z) { return __builtin_amdgcn_rcpf(1.0f + __builtin_amdgcn_exp2f(-1.4426950408889634f * z)); }
__device__ __forceinline__ float gelu_tanh(float y) { const float z2 = 1.5957691216057308f * (y + 0.044715f * y * y * y); return y * fsigmoid(z2); }

enum { MODE_MN = 0, MODE_SSM = 1, MODE_XS = 2, MODE_XPV = 3 };
template <int MODE> struct Sched {
    int nunits, G, c, nM, nN; const char* A; const char* B; size_t a_tile, b_tile;
    __device__ __forceinline__ bool next(int i, Unit& u) const {
        const long L = (long)i * G + c; if (L >= nunits) return false;
        if (MODE == MODE_MN) {
            int wgid = (int)L; const int nwg = nunits; { const int q = nwg / NXCD, r = nwg % NXCD, xcd = wgid % NXCD, off = wgid / NXCD; wgid = (xcd < r ? xcd * (q + 1) : r * (q + 1) + (xcd - r) * q) + off; }
            const int nig = WGM * nN, gid = wgid / nig, fm = gid * WGM, gsz = (nM - fm) < WGM ? (nM - fm) : WGM;
            u.pm = fm + ((wgid % nig) % gsz); u.pn = (wgid % nig) / gsz; u.z = 0;
            u.a = A + (size_t)u.pm * a_tile; u.b = B + (size_t)u.pn * b_tile;
        } else if (MODE == MODE_SSM) {
            const int g = (int)L >> 3, b = (int)L & 7; u.pm = b; u.pn = 0; u.z = g;
            u.a = A + (size_t)(g * 2048 + b * 256) * 384 * 2; u.b = B + (size_t)g * b_tile;
        } else if (MODE == MODE_XS) {
            const int h = (int)L & 3, pm = (int)L >> 2; u.pm = pm; u.pn = h; u.z = 0;
            u.a = A + ((size_t)pm * 256 * 1024 + h * 256) * 2; u.b = B + ((size_t)(pm >> 4) * 256 * 1024 + h * 256) * 2;
        } else {
            const int h = (int)L & 3, pm = (int)L >> 2; u.pm = pm; u.pn = h; u.z = 0;
            u.a = A + ((size_t)pm * 256 * 1024 + h * 256) * 2; u.b = B + ((size_t)h * 256 * 2048 + (pm >> 4) * 256) * 2;
        }
        return true;
    }
};

struct EpiPlain {
    bf16_t* O; int ldc;
    __device__ __forceinline__ void operator()(f32x4 (&acc)[2][2][4][2], const Unit& u, int wr, int wc, int fr, int fq, LAS unsigned char*) const {
        const int row0 = u.pm * BM + wr * 64 + fr, col0 = u.pn * BM + wc * 32 + 8 * fq;
#pragma unroll
        for (int ai = 0; ai < 2; ++ai)
#pragma unroll
            for (int m = 0; m < 4; ++m) { bf16_t* rowp = O + (size_t)(row0 + ai * HALF + m * 16) * ldc + col0;
#pragma unroll
                for (int bj = 0; bj < 2; ++bj) store8(rowp + bj * HALF, acc[ai][bj][m][0], acc[ai][bj][m][1]); }
    }
};
struct EpiInProj {
    bf16_t* UA; bf16_t* QKV; float qscale;
    __device__ __forceinline__ void operator()(f32x4 (&acc)[2][2][4][2], const Unit& u, int wr, int wc, int fr, int fq, LAS unsigned char*) const {
        const int colt = u.pn * BM + wc * 32 + 8 * fq;
        const float sc = (u.pn >= 2 && u.pn < 4) ? qscale : 1.0f;
#pragma unroll
        for (int ai = 0; ai < 2; ++ai)
#pragma unroll
            for (int m = 0; m < 4; ++m) { const int rowg = u.pm * BM + ai * HALF + wr * 64 + m * 16 + fr;
#pragma unroll
                for (int bj = 0; bj < 2; ++bj) { const int colg = colt + bj * HALF; bf16_t* dst;
                    if (u.pn < 2) { const int g = colg >> 4, c = colg & 15, b = rowg >> 12, t = rowg & 4095; dst = UA + ((size_t)(g * 2048 + b * 256 + (t >> 4)) * 384 + (t & 15) * 16 + c); }
                    else dst = QKV + (size_t)rowg * 1536 + (colg - 512);
                    store8(dst, acc[ai][bj][m][0] * sc, acc[ai][bj][m][1] * sc); } }
    }
};
struct EpiS1 {
    float* S;
    __device__ __forceinline__ void operator()(f32x4 (&acc)[2][2][4][2], const Unit& u, int wr, int wc, int fr, int fq, LAS unsigned char*) const {
        const int col = wc * 32 + 8 * fq;
#pragma unroll
        for (int ai = 0; ai < 2; ++ai)
#pragma unroll
            for (int m = 0; m < 4; ++m) { const int r = ai * HALF + wr * 64 + m * 16 + fr; float* dst = S + ((size_t)(u.z * 2048 + u.pm * 256 + r) * 128 + col);
                *(f32x4*)dst = acc[ai][0][m][0]; *(f32x4*)(dst + 4) = acc[ai][0][m][1]; }
    }
};
struct EpiS3 {
    bf16_t* Gb;
    __device__ __forceinline__ void operator()(f32x4 (&acc)[2][2][4][2], const Unit& u, int wr, int wc, int fr, int fq, LAS unsigned char*) const {
#pragma unroll
        for (int ai = 0; ai < 2; ++ai)
#pragma unroll
            for (int m = 0; m < 4; ++m) { const int k = ai * HALF + wr * 64 + m * 16 + fr;
#pragma unroll
                for (int bj = 0; bj < 2; ++bj) { const int col = bj * HALF + wc * 32 + 8 * fq, j = col >> 4, o = col & 15;
                    const size_t tok = (size_t)u.pm * 4096 + 16 * k + j; f32x4 v0 = acc[ai][bj][m][0], v1 = acc[ai][bj][m][1];
#pragma unroll
                    for (int e = 0; e < 4; ++e) { v0[e] = gelu_tanh(v0[e]); v1[e] = gelu_tanh(v1[e]); }
                    store8(Gb + tok * 512 + 16 * u.z + o, v0, v1); asm volatile("" ::: "memory"); } }
    }
};
struct EpiGlu {
    const bf16_t* Gb; const float* bias; bf16_t* Y;
    __device__ __forceinline__ void operator()(f32x4 (&acc)[2][2][4][2], const Unit& u, int wr, int wc, int fr, int fq, LAS unsigned char*) const {
        const int col0 = u.pn * BM + wc * 32 + 8 * fq;
#pragma unroll
        for (int bj = 0; bj < 2; ++bj) { const int col = col0 + bj * HALF; const f32x4 b0 = *(const f32x4*)(bias + col), b1 = *(const f32x4*)(bias + col + 4);
#pragma unroll
            for (int ai = 0; ai < 2; ++ai)
#pragma unroll
                for (int m = 0; m < 4; ++m) { const size_t row = (size_t)u.pm * BM + ai * HALF + wr * 64 + m * 16 + fr;
                    const u32x4 gw = *(const u32x4*)(Gb + row * 512 + col);
                    f32x4 z0 = acc[ai][bj][m][0] + b0, z1 = acc[ai][bj][m][1] + b1, o0, o1;
                    o0[0] = bf_lo(gw.x) * fsigmoid(z0[0]); o0[1] = bf_hi(gw.x) * fsigmoid(z0[1]); o0[2] = bf_lo(gw.y) * fsigmoid(z0[2]); o0[3] = bf_hi(gw.y) * fsigmoid(z0[3]);
                    o1[0] = bf_lo(gw.z) * fsigmoid(z1[0]); o1[1] = bf_hi(gw.z) * fsigmoid(z1[1]); o1[2] = bf_lo(gw.w) * fsigmoid(z1[2]); o1[3] = bf_hi(gw.w) * fsigmoid(z1[3]);
                    store8(Y + row * 1024 + col, o0, o1); } }
    }
};
struct EpiSwiglu {
    bf16_t* O; int ldc;
    __device__ __forceinline__ void operator()(f32x4 (&acc)[2][2][4][2], const Unit& u, int wr, int wc, int fr, int fq, LAS unsigned char*) const {
        const int col = u.pn * HALF + wc * 32 + 8 * fq;
#pragma unroll
        for (int ai = 0; ai < 2; ++ai)
#pragma unroll
            for (int m = 0; m < 4; ++m) { const size_t row = (size_t)u.pm * BM + ai * HALF + wr * 64 + m * 16 + fr; f32x4 o0, o1;
#pragma unroll
                for (int e = 0; e < 4; ++e) { const float g0 = acc[ai][0][m][0][e], g1 = acc[ai][0][m][1][e]; o0[e] = g0 * fsigmoid(g0) * acc[ai][1][m][0][e]; o1[e] = g1 * fsigmoid(g1) * acc[ai][1][m][1][e]; }
                store8(O + row * ldc + col, o0, o1); }
    }
};
struct EpiSoftmax {
    bf16_t* O; int ldc; float sc2;
    __device__ __forceinline__ void operator()(f32x4 (&acc)[2][2][4][2], const Unit& u, int wr, int wc, int fr, int fq, LAS unsigned char* scr) const {
        LAS float* Pm = (LAS float*)scr; LAS float* Ps = (LAS float*)(scr + 4096);
#pragma unroll
        for (int ai = 0; ai < 2; ++ai)
#pragma unroll
            for (int m = 0; m < 4; ++m) { float mx = -INFINITY;
#pragma unroll
                for (int bj = 0; bj < 2; ++bj)
#pragma unroll
                    for (int n = 0; n < 2; ++n) { const f32x4 x = acc[ai][bj][m][n]; mx = fmaxf(mx, fmaxf(fmaxf(x[0], x[1]), fmaxf(x[2], x[3]))); }
                mx = fmaxf(mx, __shfl_xor(mx, 16)); mx = fmaxf(mx, __shfl_xor(mx, 32));
                if (fq == 0) Pm[(ai * HALF + wr * 64 + m * 16 + fr) * 4 + wc] = mx; asm volatile("" ::: "memory"); }
        asm volatile("s_waitcnt lgkmcnt(0)" ::: "memory"); __builtin_amdgcn_s_barrier(); asm volatile("" ::: "memory");
#pragma unroll
        for (int ai = 0; ai < 2; ++ai)
#pragma unroll
            for (int m = 0; m < 4; ++m) { const int r = ai * HALF + wr * 64 + m * 16 + fr; const f32x4 pm4 = *(const LAS f32x4*)(Pm + r * 4);
                const float mx = fmaxf(fmaxf(pm4[0], pm4[1]), fmaxf(pm4[2], pm4[3])); float s = 0.f;
#pragma unroll
                for (int bj = 0; bj < 2; ++bj)
#pragma unroll
                    for (int n = 0; n < 2; ++n) { f32x4 x = acc[ai][bj][m][n];
#pragma unroll
                        for (int e = 0; e < 4; ++e) { x[e] = __builtin_amdgcn_exp2f((x[e] - mx) * sc2); s += x[e]; }
                        acc[ai][bj][m][n] = x; }
                s += __shfl_xor(s, 16); s += __shfl_xor(s, 32);
                if (fq == 0) Ps[r * 4 + wc] = s; asm volatile("" ::: "memory"); }
        asm volatile("s_waitcnt lgkmcnt(0)" ::: "memory"); __builtin_amdgcn_s_barrier(); asm volatile("" ::: "memory");
        const int col0 = u.pn * BM + wc * 32 + 8 * fq;
#pragma unroll
        for (int ai = 0; ai < 2; ++ai)
#pragma unroll
            for (int m = 0; m < 4; ++m) { const int r = ai * HALF + wr * 64 + m * 16 + fr; const f32x4 ps4 = *(const LAS f32x4*)(Ps + r * 4);
                const float inv = 1.0f / ((ps4[0] + ps4[1]) + (ps4[2] + ps4[3])); bf16_t* rowp = O + (size_t)(u.pm * BM + r) * ldc + col0;
#pragma unroll
                for (int bj = 0; bj < 2; ++bj) store8(rowp + bj * HALF, acc[ai][bj][m][0] * inv, acc[ai][bj][m][1] * inv); asm volatile("" ::: "memory"); }
        asm volatile("s_waitcnt lgkmcnt(0)" ::: "memory"); __builtin_amdgcn_s_barrier(); asm volatile("" ::: "memory");
    }
};

template <class Epi, class SchedT, bool ALIGN_EPI>
__device__ __forceinline__ void gemm_phase(LAS unsigned char* lds, const Gemm g, const SchedT& S, const Epi& E, LAS unsigned char* scr) {
    int tid = threadIdx.x; asm volatile("" : "+v"(tid));
    const int wid = __builtin_amdgcn_readfirstlane(tid >> 6), lane = tid & 63, wr = wid >> 2, wc = wid & 3, fr = lane & 15, fq = lane >> 4;
    const int K = g.K, nt = K / BK;
    unsigned voffA[2], voffB[2];
#pragma unroll
    for (int i = 0; i < 2; ++i) { int R, C; stage_rc(tid * 16 + i * 8192, R, C); const int Rb = (R & ~31) + perm32(R & 31);
        voffA[i] = (unsigned)(R * g.lda + C) * 2u; voffB[i] = (unsigned)(Rb * g.ldb + C) * 2u; }
    const size_t kstep = (size_t)(BK * 2);
    const size_t hstepA = (size_t)HALF * g.lda * 2, hstepB = (size_t)HALF * g.ldb * 2;
    const unsigned ldsw = (unsigned)wid * 1024u;
    const int aoff = lds_byte(wr * 64 + fr, fq * 8), boff = lds_byte(wc * 32 + fr, fq * 8);
#define PG8_SA(b, h) (((b) * 2 + (h)) * HTB)
#define PG8_SB(b, h) ((4 + (b) * 2 + (h)) * HTB)
#define PG8_STAGE(bufoff, gbase, voff) do { _Pragma("unroll") for (int _i = 0; _i < 2; ++_i) \
        __builtin_amdgcn_global_load_lds((const unsigned*)((const char*)(gbase) + (voff)[_i]), (LAS unsigned*)(lds + (bufoff) + ldsw + _i * 8192), 16, 0, 0); } while (0)
#define PG8_LDA(dst, b, h) do { _Pragma("unroll") for (int m = 0; m < 4; ++m) _Pragma("unroll") for (int k = 0; k < 2; ++k) dst[m][k] = *(const LAS bf16x8*)(lds + PG8_SA(b, h) + aoff + m * 2048 + k * 1024); } while (0)
#define PG8_LDB(dst, b, h) do { _Pragma("unroll") for (int n = 0; n < 2; ++n) _Pragma("unroll") for (int k = 0; k < 2; ++k) dst[n][k] = *(const LAS bf16x8*)(lds + PG8_SB(b, h) + boff + n * 2048 + k * 1024); } while (0)
#define PG8_MMA(ai, bj, At, Bt) do { __builtin_amdgcn_s_setprio(1); _Pragma("unroll") for (int m = 0; m < 4; ++m) _Pragma("unroll") for (int n = 0; n < 2; ++n) _Pragma("unroll") for (int k = 0; k < 2; ++k) \
        acc[ai][bj][m][n] = __builtin_amdgcn_mfma_f32_16x16x32_bf16(Bt[n][k], At[m][k], acc[ai][bj][m][n], 0, 0, 0); __builtin_amdgcn_s_setprio(0); } while (0)
#define PG8_WAIT_V(n) asm volatile("s_waitcnt vmcnt(" #n ")" ::: "memory")
#define PG8_WAIT_L(n) asm volatile("s_waitcnt lgkmcnt(" #n ")" ::: "memory")
#define PG8_BAR __builtin_amdgcn_s_barrier()
#define PG8_SCHED __builtin_amdgcn_sched_barrier(0)
    Unit cur, nxt; int ui = 0;
    if (!S.next(0, cur)) return;
    f32x4 acc[2][2][4][2];
#pragma unroll
    for (int a = 0; a < 2; ++a)
#pragma unroll
        for (int b = 0; b < 2; ++b)
#pragma unroll
            for (int m = 0; m < 4; ++m)
#pragma unroll
                for (int n = 0; n < 2; ++n) acc[a][b][m][n] = (f32x4){0.f, 0.f, 0.f, 0.f};
    bf16x8 At[4][2], B0[2][2], B1[2][2];
    const char* cA = cur.a; const char* cB = cur.b;
    PG8_STAGE(PG8_SB(0, 0), cB, voffB); PG8_STAGE(PG8_SB(0, 1), cB + hstepB, voffB); PG8_STAGE(PG8_SA(0, 0), cA, voffA); PG8_STAGE(PG8_SA(0, 1), cA + hstepA, voffA);
    if (wr == 1) PG8_BAR;
    PG8_WAIT_V(2); PG8_BAR;
    PG8_STAGE(PG8_SB(1, 0), cB + kstep, voffB); PG8_STAGE(PG8_SA(1, 0), cA + kstep, voffA); PG8_STAGE(PG8_SB(1, 1), cB + hstepB + kstep, voffB);
    PG8_WAIT_V(6); PG8_BAR;
    for (;;) {
        const bool has_next = S.next(ui + 1, nxt);
        const char* nA = has_next ? nxt.a : cA; const char* nB = has_next ? nxt.b : cB;
        for (int t = 0; t < nt; t += 2) {
            const bool last = (t == nt - 2);
            const char* a1 = cA + (size_t)(t + 1) * kstep;
            const char* a2 = last ? nA : cA + (size_t)(t + 2) * kstep; const char* b2 = last ? nB : cB + (size_t)(t + 2) * kstep;
            const char* a3 = a2 + kstep; const char* b3 = b2 + kstep;
            PG8_LDB(B0, 0, 0); PG8_LDB(B1, 0, 1); PG8_SCHED; PG8_LDA(At, 0, 0); PG8_STAGE(PG8_SA(1, 1), a1 + hstepA, voffA);
            PG8_WAIT_V(8); PG8_WAIT_L(0); PG8_BAR; PG8_MMA(0, 0, At, B0); PG8_MMA(0, 1, At, B1); PG8_BAR; PG8_SCHED;
            PG8_LDA(At, 0, 1); PG8_STAGE(PG8_SB(0, 0), b2, voffB); PG8_STAGE(PG8_SB(0, 1), b2 + hstepB, voffB); PG8_STAGE(PG8_SA(0, 0), a2, voffA);
            PG8_WAIT_V(8); PG8_WAIT_L(0); PG8_BAR; PG8_MMA(1, 0, At, B0); PG8_MMA(1, 1, At, B1); PG8_BAR; PG8_SCHED;
            PG8_LDB(B0, 1, 0); PG8_LDB(B1, 1, 1); PG8_SCHED; PG8_LDA(At, 1, 0); PG8_STAGE(PG8_SA(0, 1), a2 + hstepA, voffA);
            PG8_WAIT_V(8); PG8_WAIT_L(0); PG8_BAR; PG8_MMA(0, 0, At, B0); PG8_MMA(0, 1, At, B1); PG8_BAR; PG8_SCHED;
            PG8_LDA(At, 1, 1); PG8_STAGE(PG8_SB(1, 0), b3, voffB); PG8_STAGE(PG8_SB(1, 1), b3 + hstepB, voffB); PG8_STAGE(PG8_SA(1, 0), a3, voffA);
            PG8_WAIT_V(8); PG8_WAIT_L(0); PG8_BAR; PG8_MMA(1, 0, At, B0); PG8_MMA(1, 1, At, B1); PG8_BAR; PG8_SCHED;
        }
        if constexpr (ALIGN_EPI) { if (wr == 0) PG8_BAR; }
        { int fr2 = fr, fq2 = fq; asm volatile("" : "+v"(fr2), "+v"(fq2)); E(acc, cur, wr, wc, fr2, fq2, scr); }
        if (!has_next) break;
#pragma unroll
        for (int a = 0; a < 2; ++a)
#pragma unroll
            for (int b = 0; b < 2; ++b)
#pragma unroll
                for (int m = 0; m < 4; ++m)
#pragma unroll
                    for (int n = 0; n < 2; ++n) acc[a][b][m][n] = (f32x4){0.f, 0.f, 0.f, 0.f};
        cur = nxt; cA = nA; cB = nB; ++ui;
        if constexpr (ALIGN_EPI) { if (wr == 1) PG8_BAR; }
    }
    PG8_WAIT_V(0);
    if constexpr (!ALIGN_EPI) { if (wr == 0) PG8_BAR; }
    PG8_BAR;
#undef PG8_SA
#undef PG8_SB
#undef PG8_STAGE
#undef PG8_LDA
#undef PG8_LDB
#undef PG8_MMA
#undef PG8_WAIT_V
#undef PG8_WAIT_L
#undef PG8_BAR
#undef PG8_SCHED
}
}

namespace attn_body {
using bf16=__hip_bfloat16;
using bf16x8=__attribute__((ext_vector_type(8)))short;
using s16x4=__attribute__((ext_vector_type(4)))short;
using f32x16=__attribute__((ext_vector_type(16)))float;
using f32x4=__attribute__((ext_vector_type(4)))float;
using u32x4=__attribute__((ext_vector_type(4)))unsigned;
constexpr int BATCH=8,NHEAD=8,SEQ=4096,D=64,DM=1536,OP=1024;
constexpr int NW=8,QBLK=32,QB=QBLK*NW,KVBLK=64,NQB=SEQ/QB;
__device__ __forceinline__ int crow(int r,int hi){return (r&3)+8*(r>>2)+4*hi;}
#define SBAR() __builtin_amdgcn_sched_barrier(0)
__device__ __forceinline__ void cmask(f32x16&p0,f32x16&p1,int jb,int qrel,int hi){
  asm volatile("":"+v"(hi),"+v"(qrel));
  const float NEG=-INFINITY; int kb=64*jb+4*hi;
  #pragma unroll
  for(int r=0;r<16;++r){int kv=kb+(r&3)+8*(r>>2); if(kv>qrel)p0[r]=NEG; if(kv+32>qrel)p1[r]=NEG;}
}
constexpr int NSLOT=3, SLOTB=8192;
constexpr int LDS_K=0, LDS_V=NSLOT*SLOTB, LDS_WS=2*NSLOT*SLOTB, LDS_OST=LDS_WS+NW*64*4, LDS_F=LDS_OST+NW*4096, LDS_BYTES=LDS_F+SEQ*4;
constexpr float C2=0.125f*1.4426950408889634f;
__device__ __forceinline__ void glds16(const void*sbase,unsigned voff,unsigned lds_dst){unsigned keep;
  asm volatile("s_mov_b32 %0, m0\n\ts_mov_b32 m0, %3\n\ts_nop 0\n\tglobal_load_lds_dwordx4 %1, %2\n\ts_mov_b32 m0, %0":"=&s"(keep):"v"(voff),"s"(sbase),"s"(lds_dst):"memory");}
__device__ __forceinline__ float max3f(float a,float b,float c){float r;asm("v_max3_f32 %0, %1, %2, %3":"=v"(r):"v"(a),"v"(b),"v"(c));return r;}
__device__ __forceinline__ float max2f(float a,float b){float r;asm("v_max_f32_e32 %0, %1, %2":"=v"(r):"v"(a),"v"(b));return r;}
__device__ __forceinline__ float fadd_s(float a,float b){float r;asm("v_add_f32_e32 %0, %1, %2":"=v"(r):"v"(a),"v"(b));return r;}
__device__ __forceinline__ float fsub_s(float a,float b){float r;asm("v_sub_f32_e32 %0, %1, %2":"=v"(r):"v"(a),"v"(b));return r;}
typedef float f32x2_t __attribute__((ext_vector_type(2))); typedef __bf16 bf16x2_t __attribute__((ext_vector_type(2)));
__device__ __forceinline__ unsigned cvtpk_s(float lo,float hi){f32x2_t v={lo,hi};bf16x2_t b=__builtin_convertvector(v,bf16x2_t);return __builtin_bit_cast(unsigned,b);}
#define WAIT_BAR(N) asm volatile("s_waitcnt vmcnt(" #N ") lgkmcnt(0)\n\ts_barrier":::"memory")
__device__ __forceinline__ void qkt(f32x16&p0,f32x16&p1,const char*Kslot,const bf16x8*qr,const f32x16&negm,int r32,int hi){
  const char*kb=Kslot+hi*1024+r32*16;
  #pragma unroll
  for(int d0=0;d0<4;++d0){
    const bf16x8 b0=*reinterpret_cast<const bf16x8*>(kb+d0*2048);
    const bf16x8 b1=*reinterpret_cast<const bf16x8*>(kb+d0*2048+512);
    if(d0==0){p0=__builtin_amdgcn_mfma_f32_32x32x16_bf16(b0,qr[0],negm,0,0,0);p1=__builtin_amdgcn_mfma_f32_32x32x16_bf16(b1,qr[0],negm,0,0,0);}
    else{p0=__builtin_amdgcn_mfma_f32_32x32x16_bf16(b0,qr[d0],p0,0,0,0);p1=__builtin_amdgcn_mfma_f32_32x32x16_bf16(b1,qr[d0],p1,0,0,0);}}
}
typedef __attribute__((address_space(3))) const char* lds_cptr;
typedef short v4i16_t __attribute__((ext_vector_type(4)));
__device__ __forceinline__ void kload8(bf16x8*kf,lds_cptr kp){
  kf[0]=*(const __attribute__((address_space(3))) bf16x8*)(kp);      kf[1]=*(const __attribute__((address_space(3))) bf16x8*)(kp+512);
  kf[2]=*(const __attribute__((address_space(3))) bf16x8*)(kp+2048); kf[3]=*(const __attribute__((address_space(3))) bf16x8*)(kp+2560);
  kf[4]=*(const __attribute__((address_space(3))) bf16x8*)(kp+4096); kf[5]=*(const __attribute__((address_space(3))) bf16x8*)(kp+4608);
  kf[6]=*(const __attribute__((address_space(3))) bf16x8*)(kp+6144); kf[7]=*(const __attribute__((address_space(3))) bf16x8*)(kp+6656);
}
__device__ __forceinline__ void kload2(bf16x8*kf,lds_cptr kp,int j){ kf[2*j]=*(const __attribute__((address_space(3))) bf16x8*)(kp+j*2048); kf[2*j+1]=*(const __attribute__((address_space(3))) bf16x8*)(kp+j*2048+512); }
__device__ __forceinline__ s16x4 vtr(lds_cptr p){ return __builtin_bit_cast(s16x4,__builtin_amdgcn_ds_read_tr16_b64_v4i16((__attribute__((address_space(3))) v4i16_t*)p)); }
__device__ __forceinline__ float rowmax(const f32x16&p0,const f32x16&p1){
  float a=max3f(p0[0],p0[1],p1[0]),b=max3f(p0[2],p0[3],p1[1]);a=max3f(a,p1[2],p1[3]);
  #pragma unroll
  for(int r=4;r<16;r+=4){a=max3f(a,p0[r],p0[r+1]);b=max3f(b,p0[r+2],p0[r+3]);a=max3f(a,p1[r],p1[r+1]);b=max3f(b,p1[r+2],p1[r+3]);}
  const float m=max2f(a,b);
  auto rr=__builtin_amdgcn_permlane32_swap(__float_as_uint(m),__float_as_uint(m),false,false);
  return max2f(__uint_as_float(rr[0]),__uint_as_float(rr[1]));
}
__device__ __forceinline__ void pv(f32x16*o,int vb,bf16x8 pa0,bf16x8 pa1,bf16x8 pa2,bf16x8 pa3){
  #pragma unroll
  for(int d0=0;d0<2;++d0){s16x4 lo[4],hi[4];
    #pragma unroll
    for(int ks=0;ks<4;++ks){
      asm volatile("ds_read_b64_tr_b16 %0,%1 offset:%c2":"=&v"(lo[ks]):"v"(vb),"i"(d0*4096+ks*1024):"memory");
      asm volatile("ds_read_b64_tr_b16 %0,%1 offset:%c2":"=&v"(hi[ks]):"v"(vb),"i"(d0*4096+ks*1024+512):"memory");}
    asm volatile("s_waitcnt lgkmcnt(0)":::"memory");SBAR();
    #define PK(k) (bf16x8){lo[k][0],lo[k][1],lo[k][2],lo[k][3],hi[k][0],hi[k][1],hi[k][2],hi[k][3]}
    o[d0]=__builtin_amdgcn_mfma_f32_32x32x16_bf16(pa0,PK(0),o[d0],0,0,0);
    o[d0]=__builtin_amdgcn_mfma_f32_32x32x16_bf16(pa1,PK(1),o[d0],0,0,0);
    o[d0]=__builtin_amdgcn_mfma_f32_32x32x16_bf16(pa2,PK(2),o[d0],0,0,0);
    o[d0]=__builtin_amdgcn_mfma_f32_32x32x16_bf16(pa3,PK(3),o[d0],0,0,0);
    #undef PK
  }
}
#define ATTN_STORE16(p,v) (*(u32x4*)(p)=(v))
template<int THRL> __device__ __forceinline__ void attn_unit(int b,int h,int qb,const bf16*Q,const bf16*__restrict__ K,const bf16*__restrict__ V,bf16*O,const float*__restrict__ Fc,char*shm){
  int tid=threadIdx.x; asm volatile("":"+v"(tid));
  const int lane=tid&63,r32=lane&31,hi=lane>>5; const int wid=__builtin_amdgcn_readfirstlane(tid>>6);
  const long rowbase=(long)b*SEQ; const int q0=qb*QB;
  const bf16*Qw=Q+(rowbase+q0+wid*QBLK)*DM+h*D;
  const bf16*Kh=K+rowbase*DM+h*D,*Vh=V+rowbase*DM+h*D;
  const unsigned lds0=(unsigned)(uintptr_t)shm;
  float*wsf=(float*)(shm+LDS_WS)+wid*64;
  const lds_cptr shm3=(lds_cptr)shm;
  const int NT=(q0+QB)/KVBLK;
  const float*Fg=Fc+(long)(b*NHEAD+h)*SEQ;
  { __attribute__((address_space(3))) float* fl=(__attribute__((address_space(3))) float*)(shm3+LDS_F);
    for(int i=tid*4;i<NT*KVBLK;i+=NW*64*4){ const f32x4 v=*(const f32x4*)(Fg+i); *(__attribute__((address_space(3))) f32x4*)(fl+i)=v; } }
  const float frow=Fg[q0+wid*QBLK+r32];
  asm volatile("s_waitcnt vmcnt(0)":::"memory");
  const unsigned koff=(unsigned)(lane*DM+wid*8)*2u;
  const unsigned voff=(unsigned)((16*(wid&3)+(lane>>2))*DM+(wid>>2)*32+(lane&3)*8)*2u;
  const unsigned kdst=lds0+LDS_K+wid*1024, vdst=lds0+LDS_V+wid*1024;
  #define DMA_K(t,slot) glds16(Kh+(long)(t)*KVBLK*DM,koff,(unsigned)__builtin_amdgcn_readfirstlane(kdst+(slot)))
  #define DMA_V(t,slot) glds16(Vh+(long)(t)*KVBLK*DM,voff,(unsigned)__builtin_amdgcn_readfirstlane(vdst+(slot)))
  const char*Kbase=shm+LDS_K; bf16x8 kf[8];
  const lds_cptr kp0=shm3+LDS_K+hi*1024+r32*16; const lds_cptr vp0=shm3+LDS_V+((lane>>4)&1)*32+(lane&3)*8+(4*hi+((lane&15)>>2))*64;
  const lds_cptr fp0=shm3+LDS_F+16*hi;
  DMA_K(0,0);DMA_V(0,0);DMA_K(1,SLOTB);
  bf16x8 qr[4];
  #pragma unroll
  for(int d0=0;d0<4;++d0)qr[d0]=*reinterpret_cast<const bf16x8*>(&Qw[(long)r32*DM+d0*16+hi*8]);
  float mhat=0.f,l_reg=0.f;f32x16 o[2];o[0]=f32x16{};o[1]=f32x16{};const f32x16 negm=f32x16{};float rb=frow;
  const int qrel=wid*QBLK+r32;
  #define CMASK(P0,P1,t) do{int jb_=(t)-(NT-4); if(jb_>=0)cmask(P0,P1,jb_,qrel,hi);}while(0)
  #define KBIAS(P0,P1,t) do{ const lds_cptr fp_=fp0+(t)*256; \
    _Pragma("unroll") for(int j_=0;j_<4;++j_){ const f32x4 a_=*(const __attribute__((address_space(3))) f32x4*)(fp_+j_*32); \
      P0[4*j_]+=rb-a_[0];P0[4*j_+1]+=rb-a_[1];P0[4*j_+2]+=rb-a_[2];P0[4*j_+3]+=rb-a_[3]; } SBAR(); \
    _Pragma("unroll") for(int j_=0;j_<4;++j_){ const f32x4 b_=*(const __attribute__((address_space(3))) f32x4*)(fp_+128+j_*32); \
      P1[4*j_]+=rb-b_[0];P1[4*j_+1]+=rb-b_[1];P1[4*j_+2]+=rb-b_[2];P1[4*j_+3]+=rb-b_[3]; } SBAR(); }while(0)
  bool resc=false;
  #define START(P0,P1) do{ const float rm=rowmax(P0,P1); resc=false; \
    { const float dl=__builtin_fmaxf(rm,0.f); mhat=fadd_s(mhat,dl); \
      _Pragma("unroll") for(int r=0;r<16;++r){P0[r]=fsub_s(P0[r],dl);P1[r]=fsub_s(P1[r],dl);} \
      rb=frow-mhat; } \
    _Pragma("unroll") for(int r=0;r<16;++r)P0[r]=__builtin_amdgcn_exp2f(P0[r]); }while(0)
  #define RESC() do{ if(resc){ asm volatile("s_waitcnt lgkmcnt(0)":::"memory"); \
      _Pragma("unroll") for(int d_=0;d_<2;++d_) _Pragma("unroll") for(int r=0;r<16;++r)o[d_][r]*=wsf[crow(r,hi)]; } }while(0)
  f32x16 pA0,pA1,pB0,pB1;
  int sl_prev=0,sl_cur=0,sl_next=SLOTB;
  #define ROT() do{sl_prev=sl_cur;sl_cur=sl_next;sl_next=(sl_next==(NSLOT-1)*SLOTB)?0:sl_next+SLOTB;}while(0)
  DMA_K(2,2*SLOTB);
  WAIT_BAR(3);
  qkt(pA0,pA1,Kbase,qr,negm,r32,hi);asm volatile("s_nop 15\n\ts_nop 7":"+v"(pA0),"+v"(pA1));KBIAS(pA0,pA1,0);CMASK(pA0,pA1,0);
  START(pA0,pA1);
  _Pragma("unroll") for(int r=0;r<16;++r)pA1[r]=__builtin_amdgcn_exp2f(pA1[r]);
  WAIT_BAR(0);
  DMA_K(3,0);DMA_V(1,SLOTB);
  ROT();
  kload8(kf,kp0+sl_cur);
  WAIT_BAR(2);
  s16x4 vlo[8],vhi[8]; u32x4 pw0,pw1,pw2,pw3;
  #define PKW(P,B) cvtpk_s(P[B],P[B+1])
  #define PAF(k) __builtin_bit_cast(bf16x8,pw##k)
  #define VFR(i) (bf16x8){vlo[i][0],vlo[i][1],vlo[i][2],vlo[i][3],vhi[i][0],vhi[i][1],vhi[i][2],vhi[i][3]}
  #define PIN(x) asm volatile("":"+v"(x))
  #define MX3(a,b,c) __builtin_fmaxf(__builtin_fmaxf((a),(b)),(c))
  #define GAPA(MF,A0,A1,A2,A3,W0,W1,PW) do{ MF; sacc+=A0; sacc+=A1; sacc+=A2; sacc+=A3; PIN(sacc); W0; W1; PIN(PW); SBAR(); }while(0)
  #define EX(v) __builtin_amdgcn_exp2f(v)
  #define GAPB(MF,X,B) do{ MF; X[B]=EX(X[B]); X[B+1]=EX(X[B+1]); X[B+2]=EX(X[B+2]); X[B+3]=EX(X[B+3]); PIN(X); SBAR(); }while(0)
  #define VRD(i) do{ vlo[i]=vtr(vp_+(((i)>>2)*4096+((i)&3)*1024)); vhi[i]=vtr(vp_+(((i)>>2)*4096+((i)&3)*1024+512)); }while(0)
  #define KRD(G,j) do{ if(G){ kload2(kf,kp0+sl_next,j); SBAR(); } }while(0)
  #define STEP(C0,C1,P0,P1,t,GK,GV,GL) do{ SBAR(); \
    const lds_cptr vp_=vp0+sl_prev; \
    VRD(0); SBAR(); float sacc=(P0[0]+P0[1]); \
    GAPA(C0=__builtin_amdgcn_mfma_f32_32x32x16_bf16(kf[0],qr[0],negm,0,0,0), P0[2],P0[3],P0[4],P0[5],     pw0[0]=PKW(P0,0), pw0[1]=PKW(P0,2), pw0); \
    VRD(4); SBAR(); GAPA(C1=__builtin_amdgcn_mfma_f32_32x32x16_bf16(kf[1],qr[0],negm,0,0,0), P0[6],P0[7],P0[8],P0[9],     pw0[2]=PKW(P0,4), pw0[3]=PKW(P0,6), pw0); \
    VRD(1); SBAR(); GAPA(C0=__builtin_amdgcn_mfma_f32_32x32x16_bf16(kf[2],qr[1],C0,0,0,0),   P0[10],P0[11],P0[12],P0[13], pw1[0]=PKW(P0,8), pw1[1]=PKW(P0,10), pw1); \
    VRD(5); SBAR(); GAPA(C1=__builtin_amdgcn_mfma_f32_32x32x16_bf16(kf[3],qr[1],C1,0,0,0),   P0[14],P0[15],P1[0],P1[1],   pw1[2]=PKW(P0,12),pw1[3]=PKW(P0,14), pw1); \
    VRD(2); SBAR(); GAPA(C0=__builtin_amdgcn_mfma_f32_32x32x16_bf16(kf[4],qr[2],C0,0,0,0),   P1[2],P1[3],P1[4],P1[5],     pw2[0]=PKW(P1,0), pw2[1]=PKW(P1,2), pw2); \
    VRD(6); SBAR(); GAPA(C1=__builtin_amdgcn_mfma_f32_32x32x16_bf16(kf[5],qr[2],C1,0,0,0),   P1[6],P1[7],P1[8],P1[9],     pw2[2]=PKW(P1,4), pw2[3]=PKW(P1,6), pw2); \
    VRD(3); SBAR(); GAPA(C0=__builtin_amdgcn_mfma_f32_32x32x16_bf16(kf[6],qr[3],C0,0,0,0),   P1[10],P1[11],P1[12],P1[13], pw3[0]=PKW(P1,8), pw3[1]=PKW(P1,10), pw3); \
    VRD(7); SBAR(); GAPA(C1=__builtin_amdgcn_mfma_f32_32x32x16_bf16(kf[7],qr[3],C1,0,0,0),   P1[14],P1[15],0.f,0.f,       pw3[2]=PKW(P1,12),pw3[3]=PKW(P1,14), pw3); \
    l_reg+=sacc; \
    if(GK){DMA_K((t)+3,sl_cur);} if(GV){DMA_V((t)+1,sl_next);} \
    KBIAS(C0,C1,t); \
    CMASK(C0,C1,t); \
    { float a=MX3(C0[0],C0[1],C1[0]),b=MX3(C0[2],C0[3],C1[1]); a=MX3(a,C1[2],C1[3]); \
      _Pragma("unroll") for(int r=4;r<16;r+=4){a=MX3(a,C0[r],C0[r+1]);b=MX3(b,C0[r+2],C0[r+3]);a=MX3(a,C1[r],C1[r+1]);b=MX3(b,C1[r+2],C1[r+3]);} \
      float rm=__builtin_fmaxf(a,b); { auto rr=__builtin_amdgcn_permlane32_swap(__float_as_uint(rm),__float_as_uint(rm),false,false); rm=__builtin_fmaxf(__uint_as_float(rr[0]),__uint_as_float(rr[1])); } \
      resc=false; \
      if(__builtin_expect(__any(rm>(float)THRL),0)){ const float dl=__builtin_fmaxf(rm,0.f); mhat+=dl; \
        _Pragma("unroll") for(int r=0;r<16;++r){C0[r]-=dl;C1[r]-=dl;} \
        rb=frow-mhat; \
        const float f=__builtin_amdgcn_exp2f(-dl); l_reg*=f; if(hi==0)wsf[r32]=f; resc=true; } } \
    SBAR(); \
    GAPB(o[0]=__builtin_amdgcn_mfma_f32_32x32x16_bf16(PAF(0),VFR(0),o[0],0,0,0), C0,0); \
    GAPB(o[1]=__builtin_amdgcn_mfma_f32_32x32x16_bf16(PAF(0),VFR(4),o[1],0,0,0), C0,4); \
    KRD(GL,0); GAPB(o[0]=__builtin_amdgcn_mfma_f32_32x32x16_bf16(PAF(1),VFR(1),o[0],0,0,0), C0,8); \
    KRD(GL,1); GAPB(o[1]=__builtin_amdgcn_mfma_f32_32x32x16_bf16(PAF(1),VFR(5),o[1],0,0,0), C0,12); \
    KRD(GL,2); GAPB(o[0]=__builtin_amdgcn_mfma_f32_32x32x16_bf16(PAF(2),VFR(2),o[0],0,0,0), C1,0); \
    KRD(GL,3); GAPB(o[1]=__builtin_amdgcn_mfma_f32_32x32x16_bf16(PAF(2),VFR(6),o[1],0,0,0), C1,4); \
    GAPB(o[0]=__builtin_amdgcn_mfma_f32_32x32x16_bf16(PAF(3),VFR(3),o[0],0,0,0), C1,8); \
    GAPB(o[1]=__builtin_amdgcn_mfma_f32_32x32x16_bf16(PAF(3),VFR(7),o[1],0,0,0), C1,12); \
    }while(0)
  int t=1;
  #undef CMASK
  #define CMASK(P0,P1,t) do{}while(0)
  for(;t+5<NT;t+=2){
    STEP(pB0,pB1,pA0,pA1,t,true,true,true);     WAIT_BAR(2); RESC(); ROT();
    STEP(pA0,pA1,pB0,pB1,t+1,true,true,true);   WAIT_BAR(2); RESC(); ROT();
  }
  #undef CMASK
  #define CMASK(P0,P1,t) do{int jb_=(t)-(NT-4); if(jb_>=0)cmask(P0,P1,jb_,qrel,hi);}while(0)
  #define ENDW(tt) do{ if((tt)+3<NT){WAIT_BAR(2);} else if((tt)+2<NT){WAIT_BAR(1);} else {WAIT_BAR(0);} }while(0)
  for(;t+1<NT;t+=2){
    STEP(pB0,pB1,pA0,pA1,t,(t+3<NT),(t+1<NT),(t+1<NT));       ENDW(t);   RESC(); ROT();
    STEP(pA0,pA1,pB0,pB1,t+1,(t+4<NT),(t+2<NT),(t+2<NT));     ENDW(t+1); RESC(); ROT();
  }
  STEP(pB0,pB1,pA0,pA1,NT-1,false,false,false); RESC();
  { float sacc=pB0[0]+pB0[1]; _Pragma("unroll") for(int r=2;r<16;++r)sacc+=pB0[r]; _Pragma("unroll") for(int r=0;r<16;++r)sacc+=pB1[r]; l_reg+=sacc;
    pw0=(u32x4){PKW(pB0,0),PKW(pB0,2),PKW(pB0,4),PKW(pB0,6)};pw1=(u32x4){PKW(pB0,8),PKW(pB0,10),PKW(pB0,12),PKW(pB0,14)};pw2=(u32x4){PKW(pB1,0),PKW(pB1,2),PKW(pB1,4),PKW(pB1,6)};pw3=(u32x4){PKW(pB1,8),PKW(pB1,10),PKW(pB1,12),PKW(pB1,14)};
    int ln_=lane; asm volatile("":"+v"(ln_)); const int vb0=(int)(lds0+LDS_V)+((ln_>>4)&1)*32+(ln_&3)*8+(4*(ln_>>5)+((ln_&15)>>2))*64;
    SBAR(); pv(o,vb0+sl_cur,PAF(0),PAF(1),PAF(2),PAF(3)); }
  #undef PKW
  #undef PAF
  #undef VFR
  #undef PIN
  #undef MX3
  #undef GAPA
  #undef GAPB
  #undef EX
  #undef VRD
  #undef KRD
  #undef STEP
  #undef ENDW
  {auto rr=__builtin_amdgcn_permlane32_swap(__float_as_uint(l_reg),__float_as_uint(l_reg),false,false);l_reg=__uint_as_float(rr[0])+__uint_as_float(rr[1]);}
  if(hi==0)wsf[32+r32]=l_reg;asm volatile("s_waitcnt lgkmcnt(0)":::"memory");
  float rli[16];
  #pragma unroll
  for(int r=0;r<16;++r)rli[r]=__builtin_amdgcn_rcpf(wsf[32+crow(r,hi)]);
  bf16*Ow=O+(rowbase+q0+wid*QBLK)*OP+h*D;
  { bf16*stg=(bf16*)(shm+LDS_OST)+wid*2048;
    #pragma unroll
    for(int r=0;r<16;++r){const int orow=crow(r,hi);
      #pragma unroll
      for(int d0=0;d0<2;++d0)stg[orow*64+d0*32+r32]=__float2bfloat16(o[d0][r]*rli[r]);}
    asm volatile("s_waitcnt lgkmcnt(0)":::"memory");
    #pragma unroll
    for(int i=0;i<4;++i){const int row=i*8+(lane>>3),ch=lane&7; const u32x4 v=*(const u32x4*)(stg+row*64+ch*8); ATTN_STORE16(Ow+(long)row*OP+ch*8,v);} }
  asm volatile("s_waitcnt lgkmcnt(0)\n\ts_barrier":::"memory");
  #undef DMA_K
  #undef DMA_V
  #undef CMASK
  #undef KBIAS
  #undef START
  #undef RESC
  #undef ROT
}
constexpr int ATTN_LDS_BYTES=LDS_BYTES;
#undef SBAR
#undef WAIT_BAR
}

constexpr int NWAVES = 8, NTHR = NWAVES * 64;
constexpr int BATCH = 8, SEQ = 4096, D = 1024, M = BATCH * SEQ;
constexpr int NGRP = 32, NST = 64, SSMW = 512, FOXH = 8;
constexpr int FF = 2816, MEMT = 256, MROWS = BATCH * MEMT;
constexpr int WIN_LD = 2056;
constexpr float RMS_EPS = 1e-6f;
constexpr float LOG2E = 1.4426950408889634f;

constexpr size_t MiB = 1u << 20;
constexpr size_t WS_LOGF = 2 * MiB, WS_FCUM = 3 * MiB;
constexpr size_t WS_WIN = 4 * MiB, WS_WGLU = 8 * MiB, WS_WOUT = 9 * MiB, WS_WQ = 11 * MiB, WS_WKV = 13 * MiB, WS_WO = 17 * MiB, WS_WGU = 19 * MiB, WS_WDN = 30 * MiB;
constexpr size_t WS_W1S = 36 * MiB, WS_W3S = 40 * MiB, WS_MEMN = 46 * MiB, WS_KMEM = 50 * MiB, WS_VT = 54 * MiB;
constexpr size_t WS_H = 64 * MiB, WS_T = 128 * MiB, WS_YMIX = 192 * MiB, WS_QKV = 256 * MiB, WS_UA = 352 * MiB, WS_S = 400 * MiB, WS_G = 432 * MiB, WS_END = 464 * MiB;
constexpr size_t WS_Q2 = WS_YMIX, WS_P = WS_QKV, WS_O2 = WS_UA, WS_ACT = WS_QKV;
static_assert(WS_WGU + (size_t)2 * FF * D * 2 <= WS_WDN && WS_WDN + (size_t)D * FF * 2 <= WS_W1S && WS_W3S + (size_t)NGRP * 256 * 384 * 2 <= WS_MEMN, "ws map");
static_assert(WS_UA + (size_t)NGRP * 2048 * 384 * 2 <= WS_S && WS_S + (size_t)NGRP * 2048 * 128 * 4 <= WS_G && WS_ACT + (size_t)M * FF * 2 <= WS_G + 32 * MiB, "ws map");

constexpr int RING_BYTES = 131072, SCR_OFF = RING_BYTES, LDS_BYTES = 147456;
static_assert(attn_body::ATTN_LDS_BYTES <= RING_BYTES, "attention LDS");

typedef unsigned short bf16;
typedef unsigned v4u __attribute__((ext_vector_type(4)));
typedef float f32x4 __attribute__((ext_vector_type(4)));
#define LDS_WAIT() asm volatile("s_waitcnt lgkmcnt(0)" ::: "memory")
__device__ __forceinline__ unsigned f2bf(float f) { unsigned u = __builtin_bit_cast(unsigned, f); return (u + 0x7fffu + ((u >> 16) & 1u)) >> 16; }
__device__ __forceinline__ unsigned pk2(float lo, float hi) { return f2bf(lo) | (f2bf(hi) << 16); }
__device__ __forceinline__ float wave_sum(float v) {
#pragma unroll
    for (int o = 1; o < 64; o <<= 1) v += __shfl_xor(v, o);
    return v;
}

__device__ __forceinline__ int fresh_tid() { int t = threadIdx.x; asm volatile("" : "+v"(t)); return t; }
struct Args { const float* in[30]; float* out; unsigned char* ws; int ph_lo, ph_hi; };
typedef const __attribute__((address_space(4))) Args* KArgs;
struct Frame {
    LAS unsigned char* lds;
    int wave, vcu, G;
    KArgs kap; float* out; unsigned char* ws;
    __device__ __forceinline__ const float* inp(int i) const { KArgs p = kap; asm volatile("" : "+s"(p)); return p->in[i]; }
};

__device__ __forceinline__ void transpose_item(const float* W, int ldw, int col0, int k0, bf16* WT, int Kp, int drow, LAS float* scr, int lane) {
#pragma unroll 8
    for (int i = 0; i < 32; ++i) { const int kk = 2 * i + (lane >> 5); scr[kk * 33 + (lane & 31)] = W[(size_t)(k0 + kk) * ldw + col0 + (lane & 31)]; }
    LDS_WAIT(); asm volatile("" ::: "memory");
    const int c = lane & 7;
#pragma unroll
    for (int j = 0; j < 4; ++j) { const int n = (lane >> 3) + 8 * j; const LAS float* s = scr + (8 * c) * 33 + n;
        v4u o; o.x = pk2(s[0 * 33], s[1 * 33]); o.y = pk2(s[2 * 33], s[3 * 33]); o.z = pk2(s[4 * 33], s[5 * 33]); o.w = pk2(s[6 * 33], s[7 * 33]);
        *(v4u*)(WT + (size_t)(drow + n) * Kp + k0 + 8 * c) = o; }
    LDS_WAIT(); asm volatile("" ::: "memory");
}
__device__ __forceinline__ void cpow(float are, float aim, float dt, float tau, float& pr, float& pi) {
    const float mag = __builtin_amdgcn_exp2f(are * dt * tau * LOG2E);
    float rev = aim * dt * tau * 0.15915494309189535f; rev -= __builtin_rintf(rev);
    pr = mag * __builtin_amdgcn_cosf(rev); pi = mag * __builtin_amdgcn_sinf(rev);
}
__device__ __forceinline__ void zoh_coef(float are, float aim, float dt, float& cr, float& ci) {
    float br, bi; cpow(are, aim, dt, 1.0f, br, bi); const float nr = br - 1.0f, ni = bi, den = 1.0f / (are * are + aim * aim);
    cr = (nr * are + ni * aim) * den; ci = (ni * are - nr * aim) * den;
}
__device__ __forceinline__ void store16bf(bf16* dst, const float (&v)[16]) {
    v4u a, b; a.x = pk2(v[0], v[1]); a.y = pk2(v[2], v[3]); a.z = pk2(v[4], v[5]); a.w = pk2(v[6], v[7]); b.x = pk2(v[8], v[9]); b.y = pk2(v[10], v[11]); b.z = pk2(v[12], v[13]); b.w = pk2(v[14], v[15]);
    *(v4u*)dst = a; *(v4u*)(dst + 8) = b;
}
__device__ __forceinline__ void p0_ssm_tables(Frame& F) {
    const float* a_re = F.inp(4); const float* a_im = F.inp(5); const float* log_dt = F.inp(6); const float* b_re = F.inp(7); const float* b_im = F.inp(8);
    const float* c_re = F.inp(9); const float* c_im = F.inp(10); const float* dsk = F.inp(11);
    bf16* W1S = (bf16*)(F.ws + WS_W1S); bf16* W3S = (bf16*)(F.ws + WS_W3S);
    const int gt = F.vcu * NTHR + fresh_tid(), NT_ = F.G * NTHR;
    constexpr int NA = NGRP * 16 * 16 * 16, NB = NGRP * 16 * 16 * 64, NC = NGRP * 64 * 16;
    for (int it = gt; it < NA + NB + NC; it += NT_) {
        if (it < NA) {
            const int i = it & 15, o = (it >> 4) & 15, j = (it >> 8) & 15, g = it >> 12;
            float acc[16];
#pragma unroll
            for (int c = 0; c < 16; ++c) acc[c] = 0.f;
            if (i <= j) {
                const float dt = __expf(log_dt[g]), tau = (float)(j - i);
                for (int n = 0; n < NST; ++n) {
                    const float are = a_re[g * NST + n], aim = a_im[g * NST + n];
                    float pr, pi, cr, ci; cpow(are, aim, dt, tau, pr, pi); zoh_coef(are, aim, dt, cr, ci);
                    const float wr_ = pr * cr - pi * ci, wi_ = pr * ci + pi * cr;
                    const float Cr = c_re[(g * 16 + o) * NST + n], Ci = c_im[(g * 16 + o) * NST + n];
                    const float qr = Cr * wr_ - Ci * wi_, qi = Cr * wi_ + Ci * wr_;
                    const f32x4* br = (const f32x4*)(b_re + (size_t)(g * NST + n) * 16); const f32x4* bi = (const f32x4*)(b_im + (size_t)(g * NST + n) * 16);
#pragma unroll
                    for (int c4 = 0; c4 < 4; ++c4) { const f32x4 x = br[c4], y = bi[c4];
#pragma unroll
                        for (int e = 0; e < 4; ++e) acc[4 * c4 + e] += qr * x[e] - qi * y[e]; }
                }
                if (i == j) { const float dv = dsk[g * 16 + o];
#pragma unroll
                    for (int c = 0; c < 16; ++c) acc[c] += (c == o) ? dv : 0.f; }
            }
            store16bf(W3S + ((size_t)(g * 256 + j * 16 + o) * 384 + i * 16), acc);
        } else if (it < NA + NB) {
            const int r = it - NA, n = r & 63, o = (r >> 6) & 15, j = (r >> 10) & 15, g = r >> 14;
            const float dt = __expf(log_dt[g]); float pr, pi; cpow(a_re[g * NST + n], a_im[g * NST + n], dt, (float)(j + 1), pr, pi);
            const float Cr = c_re[(g * 16 + o) * NST + n], Ci = c_im[(g * 16 + o) * NST + n];
            bf16* row = W3S + (size_t)(g * 256 + j * 16 + o) * 384;
            row[256 + n] = (bf16)f2bf(Cr * pr - Ci * pi); row[320 + n] = (bf16)f2bf(-(Cr * pi + Ci * pr));
        } else {
            const int r = it - NA - NB, i = r & 15, n = (r >> 4) & 63, g = r >> 10;
            const float dt = __expf(log_dt[g]), are = a_re[g * NST + n], aim = a_im[g * NST + n];
            float pr, pi, cr, ci; cpow(are, aim, dt, (float)(15 - i), pr, pi); zoh_coef(are, aim, dt, cr, ci);
            const float wr_ = pr * cr - pi * ci, wi_ = pr * ci + pi * cr;
            float vr[16], vi[16];
            const f32x4* br = (const f32x4*)(b_re + (size_t)(g * NST + n) * 16); const f32x4* bi = (const f32x4*)(b_im + (size_t)(g * NST + n) * 16);
#pragma unroll
            for (int c4 = 0; c4 < 4; ++c4) { const f32x4 x = br[c4], y = bi[c4];
#pragma unroll
                for (int e = 0; e < 4; ++e) { vr[4 * c4 + e] = wr_ * x[e] - wi_ * y[e]; vi[4 * c4 + e] = wr_ * y[e] + wi_ * x[e]; } }
            store16bf(W1S + ((size_t)(g * 256 + n) * 256 + i * 16), vr);
            store16bf(W1S + ((size_t)(g * 256 + 64 + n) * 256 + i * 16), vi);
        }
    }
}
__device__ __forceinline__ void rms_row_to_bf16(const float* xrow, const float* gain, bf16* orow, int lane, f32x4 (&v)[4], float& rstd) {
    const f32x4* xr = (const f32x4*)xrow + lane; float s = 0.f;
#pragma unroll
    for (int j = 0; j < 4; ++j) { v[j] = xr[64 * j]; s += (v[j].x * v[j].x + v[j].y * v[j].y) + (v[j].z * v[j].z + v[j].w * v[j].w); }
    rstd = 1.0f / sqrtf(wave_sum(s) * (1.f / D) + RMS_EPS);
    unsigned long long* o8 = (unsigned long long*)orow + lane;
#pragma unroll
    for (int j = 0; j < 4; ++j) { const f32x4 gv = ((const f32x4*)gain)[64 * j + lane]; v[j] = v[j] * rstd * gv;
        o8[64 * j] = (unsigned long long)pk2(v[j].x, v[j].y) | ((unsigned long long)pk2(v[j].z, v[j].w) << 32); }
}
__device__ __forceinline__ void p0_prologue(Frame& F) {
    const int tid_ = fresh_tid(), lane_ = tid_ & 63;
    LAS float* scr = (LAS float*)(F.lds + F.wave * 16384);
    const int gw = F.vcu * NWAVES + F.wave, NGW = F.G * NWAVES;
    bf16* ws16 = (bf16*)F.ws;
    constexpr int I_IN = 16 * 64, I_GLU = 8 * 16, I_SQ = 16 * 32, I_KV = 16 * 64, I_GU = 16 * 88, I_DN = 44 * 32;
    constexpr int NITEMS = I_IN + I_GLU + 3 * I_SQ + I_KV + 2 * I_GU + I_DN;
    for (int it = gw; it < NITEMS; it += NGW) {
        int r = it;
        if (r < I_IN) { transpose_item(F.inp(3), WIN_LD, 32 * (r % 64), 64 * (r / 64), (bf16*)(F.ws + WS_WIN), 1024, 32 * (r % 64), scr, lane_); continue; } r -= I_IN;
        if (r < I_GLU) { transpose_item(F.inp(12), 512, 32 * (r % 16), 64 * (r / 16), (bf16*)(F.ws + WS_WGLU), 512, 32 * (r % 16), scr, lane_); continue; } r -= I_GLU;
        if (r < I_SQ) { transpose_item(F.inp(17), 1024, 32 * (r % 32), 64 * (r / 32), (bf16*)(F.ws + WS_WOUT), 1024, 32 * (r % 32), scr, lane_); continue; } r -= I_SQ;
        if (r < I_SQ) { transpose_item(F.inp(21), 1024, 32 * (r % 32), 64 * (r / 32), (bf16*)(F.ws + WS_WQ), 1024, 32 * (r % 32), scr, lane_); continue; } r -= I_SQ;
        if (r < I_KV) { transpose_item(F.inp(22), 2048, 32 * (r % 64), 64 * (r / 64), (bf16*)(F.ws + WS_WKV), 1024, 32 * (r % 64), scr, lane_); continue; } r -= I_KV;
        if (r < I_SQ) { transpose_item(F.inp(23), 1024, 32 * (r % 32), 64 * (r / 32), (bf16*)(F.ws + WS_WO), 1024, 32 * (r % 32), scr, lane_); continue; } r -= I_SQ;
        if (r < I_GU) { const int n0 = 32 * (r % 88); transpose_item(F.inp(26), FF, n0, 64 * (r / 88), (bf16*)(F.ws + WS_WGU), 1024, (n0 / 128) * 256 + (n0 % 128), scr, lane_); continue; } r -= I_GU;
        if (r < I_GU) { const int n0 = 32 * (r % 88); transpose_item(F.inp(27), FF, n0, 64 * (r / 88), (bf16*)(F.ws + WS_WGU), 1024, (n0 / 128) * 256 + 128 + (n0 % 128), scr, lane_); continue; } r -= I_GU;
        transpose_item(F.inp(28), 1024, 32 * (r % 32), 64 * (r / 32), (bf16*)(F.ws + WS_WDN), FF, 32 * (r % 32), scr, lane_);
    }
    (void)ws16;
    p0_ssm_tables(F);
    __syncthreads();
    LAS float* wf = (LAS float*)F.lds;
    { const float* w_in = F.inp(3); for (int i = tid_; i < D * 8; i += NTHR) wf[i] = w_in[(size_t)(i >> 3) * WIN_LD + 2048 + (i & 7)]; }
    const float* xin_ = F.inp(0); const float* g_pre = F.inp(2); const float* fbias = F.inp(14);
    __syncthreads();
    float* LOGF = (float*)(F.ws + WS_LOGF);
    for (int m = gw; m < M; m += NGW) {
        f32x4 v[4]; float rstd; rms_row_to_bf16(xin_ + (size_t)m * D, g_pre, (bf16*)(F.ws + WS_H) + (size_t)m * D, lane_, v, rstd);
        float fs[8];
#pragma unroll
        for (int h = 0; h < 8; ++h) fs[h] = 0.f;
#pragma unroll
        for (int j = 0; j < 4; ++j)
#pragma unroll
            for (int e = 0; e < 4; ++e) { const int k = 256 * j + 4 * lane_ + e; const f32x4 w0 = *(const LAS f32x4*)(wf + k * 8), w1 = *(const LAS f32x4*)(wf + k * 8 + 4); const float hv = v[j][e];
                fs[0] += hv * w0[0]; fs[1] += hv * w0[1]; fs[2] += hv * w0[2]; fs[3] += hv * w0[3]; fs[4] += hv * w1[0]; fs[5] += hv * w1[1]; fs[6] += hv * w1[2]; fs[7] += hv * w1[3]; }
#pragma unroll
        for (int h = 0; h < 8; ++h) fs[h] = wave_sum(fs[h]);
        if (lane_ < 8) { const int h = lane_;
            float z = (h == 0) ? fs[0] : (h == 1) ? fs[1] : (h == 2) ? fs[2] : (h == 3) ? fs[3] : (h == 4) ? fs[4] : (h == 5) ? fs[5] : (h == 6) ? fs[6] : fs[7];
            z += fbias[h];
            const float ls = fminf(z, 0.f) - log1pf(__expf(-fabsf(z)));
            LOGF[(size_t)((m >> 12) * FOXH + h) * SEQ + (m & 4095)] = ls; }
    }
    const float* mem_ = F.inp(1); const float* memg = F.inp(20);
    for (int m = gw; m < MROWS; m += NGW) { f32x4 v[4]; float rstd; rms_row_to_bf16(mem_ + (size_t)m * D, memg, (bf16*)(F.ws + WS_MEMN) + (size_t)m * D, lane_, v, rstd); }
}
__device__ __forceinline__ void cumsum_phase(Frame& F) {
    const int tid_ = fresh_tid(), lane_ = tid_ & 63;
    LAS float* wtot = (LAS float*)(F.lds + SCR_OFF);
    const float* LOGF = (const float*)(F.ws + WS_LOGF); float* FCUM = (float*)(F.ws + WS_FCUM);
    for (int seq = F.vcu; seq < BATCH * FOXH; seq += F.G) {
        const f32x4* src = (const f32x4*)(LOGF + (size_t)seq * SEQ + 8 * tid_); f32x4 a = src[0], b = src[1];
        a[1] += a[0]; a[2] += a[1]; a[3] += a[2]; b[0] += a[3]; b[1] += b[0]; b[2] += b[1]; b[3] += b[2];
        float inc = b[3];
#pragma unroll
        for (int o = 1; o < 64; o <<= 1) { const float nb = __shfl_up(inc, o); if (lane_ >= o) inc += nb; }
        if (lane_ == 63) wtot[F.wave] = inc;
        __syncthreads();
        float base = inc - b[3];
        for (int w = 0; w < F.wave; ++w) base += wtot[w];
        f32x4* dst = (f32x4*)(FCUM + (size_t)seq * SEQ + 8 * tid_);
        dst[0] = (a + base) * LOG2E; dst[1] = (b + base) * LOG2E;
        __syncthreads();
    }
}
__device__ __forceinline__ void ssm_scan_item(Frame& F, int g, int b) {
    const int n = fresh_tid() & 63;
    const float dt = __expf(F.inp(6)[g]); float Ar, Ai; cpow(F.inp(4)[g * NST + n], F.inp(5)[g * NST + n], dt, 16.0f, Ar, Ai);
    const float* S = (const float*)(F.ws + WS_S) + (size_t)(g * 2048 + b * 256) * 128; bf16* UA = (bf16*)(F.ws + WS_UA) + (size_t)(g * 2048 + b * 256) * 384;
    float hr = 0.f, hi = 0.f;
#pragma unroll 8
    for (int k = 0; k < 256; ++k) {
        const float sr = S[k * 128 + n], si = S[k * 128 + 64 + n];
        UA[k * 384 + 256 + n] = (bf16)f2bf(hr); UA[k * 384 + 320 + n] = (bf16)f2bf(hi);
        const float nr = Ar * hr - Ai * hi + sr, ni = Ar * hi + Ai * hr + si; hr = nr; hi = ni;
    }
}
__device__ __forceinline__ void rowpass_mix(Frame& F) {
    const int lane_ = fresh_tid() & 63;
    const int gw = F.vcu * NWAVES + F.wave, NGW = F.G * NWAVES; const float* g1 = F.inp(15); const float* g2 = F.inp(16);
    for (int m = gw; m < M; m += NGW) {
        v4u* row = (v4u*)((bf16*)(F.ws + WS_YMIX) + (size_t)m * D);
#pragma unroll
        for (int hf = 0; hf < 2; ++hf) { const v4u w = row[hf * 64 + lane_]; float x[8];
            x[0] = pg8::bf_lo(w.x); x[1] = pg8::bf_hi(w.x); x[2] = pg8::bf_lo(w.y); x[3] = pg8::bf_hi(w.y); x[4] = pg8::bf_lo(w.z); x[5] = pg8::bf_hi(w.z); x[6] = pg8::bf_lo(w.w); x[7] = pg8::bf_hi(w.w);
            float s = 0.f;
#pragma unroll
            for (int e = 0; e < 8; ++e) s += x[e] * x[e];
            const float rstd = 1.0f / sqrtf(wave_sum(s) * (1.f / 512.f) + RMS_EPS);
            const float* gp = (hf ? g2 : g1) + 8 * lane_; const f32x4 ga = *(const f32x4*)gp, gb = *(const f32x4*)(gp + 4);
            v4u o; o.x = pk2(x[0] * rstd * ga[0], x[1] * rstd * ga[1]); o.y = pk2(x[2] * rstd * ga[2], x[3] * rstd * ga[3]); o.z = pk2(x[4] * rstd * gb[0], x[5] * rstd * gb[1]); o.w = pk2(x[6] * rstd * gb[2], x[7] * rstd * gb[3]);
            row[hf * 64 + lane_] = o; }
    }
}
__device__ __forceinline__ void rowpass_res(Frame& F, const float* xin, float* xo, const float* gpost, const float* gpre) {
    const int lane_ = fresh_tid() & 63;
    const int gw = F.vcu * NWAVES + F.wave, NGW = F.G * NWAVES;
    for (int m = gw; m < M; m += NGW) {
        const unsigned long long* tr = (const unsigned long long*)((const bf16*)(F.ws + WS_T) + (size_t)m * D) + lane_;
        const f32x4* xr = (const f32x4*)(xin + (size_t)m * D) + lane_;
        f32x4 t[4], x[4]; float s = 0.f;
#pragma unroll
        for (int j = 0; j < 4; ++j) { const unsigned long long w = tr[64 * j]; x[j] = xr[64 * j];
            t[j] = (f32x4){pg8::bf_lo((unsigned)w), pg8::bf_hi((unsigned)w), pg8::bf_lo((unsigned)(w >> 32)), pg8::bf_hi((unsigned)(w >> 32))};
            s += (t[j].x * t[j].x + t[j].y * t[j].y) + (t[j].z * t[j].z + t[j].w * t[j].w); }
        const float rstd = 1.0f / sqrtf(wave_sum(s) * (1.f / D) + RMS_EPS); float s2 = 0.f;
        f32x4* orow = (f32x4*)(xo + (size_t)m * D) + lane_;
#pragma unroll
        for (int j = 0; j < 4; ++j) { const f32x4 gv = ((const f32x4*)gpost)[64 * j + lane_]; x[j] = x[j] + t[j] * rstd * gv; orow[64 * j] = x[j];
            s2 += (x[j].x * x[j].x + x[j].y * x[j].y) + (x[j].z * x[j].z + x[j].w * x[j].w); }
        if (gpre) { const float r2 = 1.0f / sqrtf(wave_sum(s2) * (1.f / D) + RMS_EPS);
            unsigned long long* o8 = (unsigned long long*)((bf16*)(F.ws + WS_H) + (size_t)m * D) + lane_;
#pragma unroll
            for (int j = 0; j < 4; ++j) { const f32x4 gv = ((const f32x4*)gpre)[64 * j + lane_]; const f32x4 hv = x[j] * r2 * gv;
                o8[64 * j] = (unsigned long long)pk2(hv.x, hv.y) | ((unsigned long long)pk2(hv.z, hv.w) << 32); } }
    }
}

constexpr int N_PHASES = 16;
__global__ void __launch_bounds__(NTHR, 2) mk_fwd(Args args) {
    __builtin_assume(__builtin_amdgcn_workitem_id_y() == 0); __builtin_assume(__builtin_amdgcn_workitem_id_z() == 0);
    extern __shared__ __attribute__((aligned(16))) unsigned char lds[];
    Frame F;
    F.lds = (LAS unsigned char*)lds;
    F.wave = __builtin_amdgcn_readfirstlane((int)threadIdx.x >> 6);
    F.G = gridDim.x; { const int bx = blockIdx.x; F.vcu = (F.G % 8 == 0) ? (bx % 8) * (F.G / 8) + bx / 8 : bx; }
    F.kap = (KArgs)__builtin_amdgcn_kernarg_segment_ptr();
    F.out = args.out; F.ws = args.ws;
    LAS unsigned char* ring = F.lds; LAS unsigned char* scr = F.lds + SCR_OFF;
    const int lo = args.ph_lo, hi = args.ph_hi, bx = (int)blockIdx.x, G = F.G;
#ifndef ONLY_PHASE
#define ONLY_PHASE -1
#endif
#define IN(k) ((ONLY_PHASE < 0 || ONLY_PHASE == (k)) && lo <= (k) && (k) < hi)
#define SEAM(k) do { if (IN(k) && IN((k) + 1)) cg::this_grid().sync(); } while (0)
    using namespace pg8;
    const char* wsc = (const char*)F.ws;

    if (IN(0)) { p0_prologue(F); } SEAM(0);

    if (IN(1)) {
        Gemm g{1024, 1024, 1024}; Sched<MODE_MN> S{128 * 8, G, bx, 128, 8, wsc + WS_H, wsc + WS_WIN, (size_t)256 * 1024 * 2, (size_t)256 * 1024 * 2};
        EpiInProj E{(bf16_t*)(F.ws + WS_UA), (bf16_t*)(F.ws + WS_QKV), attn_body::C2};
        gemm_phase<EpiInProj, Sched<MODE_MN>, true>(ring, g, S, E, scr);
    } SEAM(1);

    if (IN(2)) {
        cumsum_phase(F);
        { Gemm g{384, 256, 256}; Sched<MODE_SSM> S{256, G, bx, 0, 0, wsc + WS_UA, wsc + WS_W1S, 0, (size_t)256 * 256 * 2};
          EpiS1 E{(float*)(F.ws + WS_S)}; gemm_phase<EpiS1, Sched<MODE_SSM>, true>(ring, g, S, E, scr); }
        { Gemm g{1024, 1024, 1024}; Sched<MODE_MN> S{8 * 4, G, bx, 8, 4, wsc + WS_MEMN, wsc + WS_WKV, (size_t)256 * 1024 * 2, (size_t)256 * 1024 * 2};
          EpiPlain E{(bf16_t*)(F.ws + WS_KMEM), 1024}; gemm_phase<EpiPlain, Sched<MODE_MN>, true>(ring, g, S, E, scr); }
        { Gemm g{1024, 1024, 1024}; Sched<MODE_MN> S{4 * 8, G, (bx + G - 32) % G, 4, 8, wsc + WS_WKV + (size_t)1024 * 1024 * 2, wsc + WS_MEMN, (size_t)256 * 1024 * 2, (size_t)256 * 1024 * 2};
          EpiPlain E{(bf16_t*)(F.ws + WS_VT), 2048}; gemm_phase<EpiPlain, Sched<MODE_MN>, true>(ring, g, S, E, scr); }
    } SEAM(2);

    if (IN(3)) {
        const attn_body::bf16* QKV = (const attn_body::bf16*)(F.ws + WS_QKV);
        for (int quad = F.vcu; quad < 256; quad += G) {
            const int bh = quad >> 2, s = quad & 3;
#pragma unroll 1
            for (int i = 0; i < 4; ++i) { const int qb = (i == 0) ? s : (i == 1) ? 7 - s : (i == 2) ? 8 + s : 15 - s;
                attn_body::attn_unit<8>(bh >> 3, bh & 7, qb, QKV, QKV + 512, QKV + 1024, (attn_body::bf16*)(F.ws + WS_YMIX) + 512, (const float*)(F.ws + WS_FCUM), (char*)lds); }
        }
    }

    if (IN(4)) {
        __syncthreads();
        if (F.wave == 0) for (int L = bx; L < 256; L += G) ssm_scan_item(F, L >> 3, L & 7);
        __threadfence(); __syncthreads();
        Gemm g{384, 384, 384}; Sched<MODE_SSM> S{256, G, bx, 0, 0, wsc + WS_UA, wsc + WS_W3S, 0, (size_t)256 * 384 * 2};
        EpiS3 E{(bf16_t*)(F.ws + WS_G)}; gemm_phase<EpiS3, Sched<MODE_SSM>, true>(ring, g, S, E, scr);
    } SEAM(4);

    if (IN(5)) {
        Gemm g{512, 512, 512}; Sched<MODE_MN> S{128 * 2, G, bx, 128, 2, wsc + WS_G, wsc + WS_WGLU, (size_t)256 * 512 * 2, (size_t)256 * 512 * 2};
        EpiGlu E{(const bf16_t*)(F.ws + WS_G), F.inp(13), (bf16_t*)(F.ws + WS_YMIX)}; gemm_phase<EpiGlu, Sched<MODE_MN>, true>(ring, g, S, E, scr);
    } SEAM(5);

    if (IN(6)) { rowpass_mix(F); } SEAM(6);

    if (IN(7)) {
        Gemm g{1024, 1024, 1024}; Sched<MODE_MN> S{128 * 4, G, bx, 128, 4, wsc + WS_YMIX, wsc + WS_WOUT, (size_t)256 * 1024 * 2, (size_t)256 * 1024 * 2};
        EpiPlain E{(bf16_t*)(F.ws + WS_T), 1024}; gemm_phase<EpiPlain, Sched<MODE_MN>, true>(ring, g, S, E, scr);
    } SEAM(7);

    if (IN(8)) { rowpass_res(F, F.inp(0), F.out, F.inp(18), F.inp(19)); } SEAM(8);

    if (IN(9)) {
        Gemm g{1024, 1024, 1024}; Sched<MODE_MN> S{128 * 4, G, bx, 128, 4, wsc + WS_H, wsc + WS_WQ, (size_t)256 * 1024 * 2, (size_t)256 * 1024 * 2};
        EpiPlain E{(bf16_t*)(F.ws + WS_Q2), 1024}; gemm_phase<EpiPlain, Sched<MODE_MN>, true>(ring, g, S, E, scr);
    } SEAM(9);

    if (IN(10)) {
        Gemm g{1024, 1024, 256}; Sched<MODE_XS> S{128 * 4, G, bx, 0, 0, wsc + WS_Q2, wsc + WS_KMEM, 0, 0};
        EpiSoftmax E{(bf16_t*)(F.ws + WS_P), 1024, 0.0625f * LOG2E}; gemm_phase<EpiSoftmax, Sched<MODE_XS>, true>(ring, g, S, E, scr);
    } SEAM(10);

    if (IN(11)) {
        Gemm g{1024, 2048, 256}; Sched<MODE_XPV> S{128 * 4, G, bx, 0, 0, wsc + WS_P, wsc + WS_VT, 0, 0};
        EpiPlain E{(bf16_t*)(F.ws + WS_O2), 1024}; gemm_phase<EpiPlain, Sched<MODE_XPV>, true>(ring, g, S, E, scr);
    } SEAM(11);

    if (IN(12)) {
        Gemm g{1024, 1024, 1024}; Sched<MODE_MN> S{128 * 4, G, bx, 128, 4, wsc + WS_O2, wsc + WS_WO, (size_t)256 * 1024 * 2, (size_t)256 * 1024 * 2};
        EpiPlain E{(bf16_t*)(F.ws + WS_T), 1024}; gemm_phase<EpiPlain, Sched<MODE_MN>, true>(ring, g, S, E, scr);
    } SEAM(12);

    if (IN(13)) { rowpass_res(F, F.out, F.out, F.inp(24), F.inp(25)); } SEAM(13);

    if (IN(14)) {
        Gemm g{1024, 1024, 1024}; Sched<MODE_MN> S{128 * 22, G, bx, 128, 22, wsc + WS_H, wsc + WS_WGU, (size_t)256 * 1024 * 2, (size_t)256 * 1024 * 2};
        EpiSwiglu E{(bf16_t*)(F.ws + WS_ACT), FF}; gemm_phase<EpiSwiglu, Sched<MODE_MN>, true>(ring, g, S, E, scr);
    } SEAM(14);

    if (IN(15)) {
        Gemm g{FF, FF, FF}; Sched<MODE_MN> S{128 * 4, G, bx, 128, 4, wsc + WS_ACT, wsc + WS_WDN, (size_t)256 * FF * 2, (size_t)256 * FF * 2};
        EpiPlain E{(bf16_t*)(F.ws + WS_T), 1024}; gemm_phase<EpiPlain, Sched<MODE_MN>, true>(ring, g, S, E, scr);
    } SEAM(15);
    if (IN(16)) { rowpass_res(F, F.out, F.out, F.inp(29), nullptr); }
#undef IN
#undef SEAM
}

extern "C" void kernel_launch(void* const* d_in, const int* in_sizes, int n_in, void* d_out, int out_size, void* d_ws, size_t ws_size, hipStream_t stream) {
    static int grid = 0;
    if (grid == 0) {
        if (n_in != 30 || in_sizes[0] != M * D || out_size != M * D || ws_size < WS_END) { fprintf(stderr, "kernel_launch: unexpected shapes (n_in %d, in0 %d, out %d, ws %zu)\n", n_in, n_in > 0 ? in_sizes[0] : -1, out_size, ws_size); grid = -1; return; }
        int dev = 0, cus = 0, per_cu = 0;
        if (hipGetDevice(&dev) != hipSuccess || hipDeviceGetAttribute(&cus, hipDeviceAttributeMultiprocessorCount, dev) != hipSuccess) { grid = -1; return; }
        if (hipFuncSetAttribute((const void*)mk_fwd, hipFuncAttributeMaxDynamicSharedMemorySize, LDS_BYTES) != hipSuccess) { fprintf(stderr, "kernel_launch: hipFuncSetAttribute failed\n"); grid = -1; return; }
        if (hipOccupancyMaxActiveBlocksPerMultiprocessor(&per_cu, (const void*)mk_fwd, NTHR, LDS_BYTES) != hipSuccess || per_cu < 1) { fprintf(stderr, "kernel_launch: occupancy query says %d\n", per_cu); per_cu = 1; }
        (void)hipGetLastError();
        grid = cus;
    }
    if (grid < 0) return;
    Args a{};
    for (int i = 0; i < 30; ++i) a.in[i] = (const float*)d_in[i];
    a.out = (float*)d_out; a.ws = (unsigned char*)d_ws;
#if MK_COOP
    a.ph_lo = 0; a.ph_hi = N_PHASES + 1;
    void* kargs[] = {&a};
    const hipError_t le = hipLaunchCooperativeKernel((const void*)mk_fwd, dim3(grid), dim3(NTHR), kargs, LDS_BYTES, stream);
    if (le != hipSuccess) fprintf(stderr, "kernel_launch: cooperative launch failed: %s (grid %d)\n", hipGetErrorName(le), grid);
#else
    const int cuts[] = {0, 1, 2, 3, 5, 6, 7, 8, 9, 10, 11, 12, 13, 14, 15, 16, 17};
    for (int li = 0; li + 1 < (int)(sizeof(cuts) / sizeof(int)); ++li) {
        a.ph_lo = cuts[li]; a.ph_hi = cuts[li + 1];
        hipLaunchKernelGGL(mk_fwd, dim3(grid), dim3(NTHR), LDS_BYTES, stream, a);
    }
#endif
}
```

```cpp
#include <hip/hip_runtime.h>
#include <hip/hip_cooperative_groups.h>
#include <hip/hip_bf16.h>
#include <cstdio>
#include <cstdint>
#include <cmath>
namespace cg = cooperative_groups;

#ifndef MK_COOP
#define MK_COOP 1
#endif
#define DUP_SEAM 1
#define DUP_PHASE -1

#define LAS __attribute__((address_space(3)))
#define GAS __attribute__((address_space(1)))

namespace pg8 {
typedef unsigned short bf16_t;
typedef short bf16x8 __attribute__((ext_vector_type(8)));
typedef float f32x4 __attribute__((ext_vector_type(4)));
typedef float f32x2 __attribute__((ext_vector_type(2)));
typedef unsigned u32x4 __attribute__((ext_vector_type(4)));
typedef unsigned u32x2 __attribute__((ext_vector_type(2)));
constexpr int BM = 256, BK = 64, HALF = 128, HTB = HALF * BK * 2, STAGE_BYTES = 8 * HTB, NXCD = 8, WGM = 8;

__host__ __device__ __forceinline__ int lds_byte(int r, int c) { const int st = (r >> 4) * 2 + (c >> 5), rr = r & 15, cc = c & 31, ob = rr * 64 + cc * 2; return st * 1024 + (ob ^ (((ob >> 9) & 1) << 5)); }
__host__ __device__ __forceinline__ void stage_rc(int b, int& R, int& C) { const int st = b / 1024, sb = b % 1024, swz = sb ^ (((sb >> 9) & 1) << 5); R = (st >> 1) * 16 + swz / 64; C = (st & 1) * 32 + (swz % 64) / 2; }
__host__ __device__ __forceinline__ int perm32(int rho) { const int n = rho >> 4, i = rho & 15; return 8 * (i >> 2) + 4 * n + (i & 3); }

struct Unit { int pm, pn, z; const char* a; const char* b; };
struct Gemm { int lda, ldb, K; };

__device__ __forceinline__ unsigned cvt_pk_bf16(float lo, float hi) { unsigned r; asm volatile("v_cvt_pk_bf16_f32 %0, %1, %2" : "=v"(r) : "v"(lo), "v"(hi)); return r; }
__device__ __forceinline__ void store8(bf16_t* p, f32x4 v0, f32x4 v1) { u32x4 w; w.x = cvt_pk_bf16(v0[0], v0[1]); w.y = cvt_pk_bf16(v0[2], v0[3]); w.z = cvt_pk_bf16(v1[0], v1[1]); w.w = cvt_pk_bf16(v1[2], v1[3]); *(u32x4*)p = w; }
__device__ __forceinline__ float bf_lo(unsigned w) { return __uint_as_float(w << 16); }
__device__ __forceinline__ float bf_hi(unsigned w) { return __uint_as_float(w & 0xffff0000u); }
__device__ __forceinline__ float fsigmoid(float z) { return __builtin_amdgcn_rcpf(1.0f + __builtin_amdgcn_exp2f(-1.4426950408889634f * z)); }
__device__ __forceinline__ float gelu_tanh(float y) { const float z2 = 1.5957691216057308f * (y + 0.044715f * y * y * y); return y * fsigmoid(z2); }

enum { MODE_MN = 0, MODE_SSM = 1, MODE_XS = 2, MODE_XPV = 3 };
template <int MODE> struct Sched {
    int nunits, G, c, nM, nN; const char* A; const char* B; size_t a_tile, b_tile;
    __device__ __forceinline__ bool next(int i, Unit& u) const {
        const long L = (long)i * G + c; if (L >= nunits) return false;
        if (MODE == MODE_MN) {
            int wgid = (int)L; const int nwg = nunits; { const int q = nwg / NXCD, r = nwg % NXCD, xcd = wgid % NXCD, off = wgid / NXCD; wgid = (xcd < r ? xcd * (q + 1) : r * (q + 1) + (xcd - r) * q) + off; }
            const int nig = WGM * nN, gid = wgid / nig, fm = gid * WGM, gsz = (nM - fm) < WGM ? (nM - fm) : WGM;
            u.pm = fm + ((wgid % nig) % gsz); u.pn = (wgid % nig) / gsz; u.z = 0;
            u.a = A + (size_t)u.pm * a_tile; u.b = B + (size_t)u.pn * b_tile;
        } else if (MODE == MODE_SSM) {
            const int g = (int)L >> 3, b = (int)L & 7; u.pm = b; u.pn = 0; u.z = g;
            u.a = A + (size_t)(g * 2048 + b * 256) * 384 * 2; u.b = B + (size_t)g * b_tile;
        } else if (MODE == MODE_XS) {
            const int h = (int)L & 3, pm = (int)L >> 2; u.pm = pm; u.pn = h; u.z = 0;
            u.a = A + ((size_t)pm * 256 * 1024 + h * 256) * 2; u.b = B + ((size_t)(pm >> 4) * 256 * 1024 + h * 256) * 2;
        } else {
            const int h = (int)L & 3, pm = (int)L >> 2; u.pm = pm; u.pn = h; u.z = 0;
            u.a = A + ((size_t)pm * 256 * 1024 + h * 256) * 2; u.b = B + ((size_t)h * 256 * 2048 + (pm >> 4) * 256) * 2;
        }
        return true;
    }
};

struct EpiPlain {
    bf16_t* O; int ldc;
    __device__ __forceinline__ void operator()(f32x4 (&acc)[2][2][4][2], const Unit& u, int wr, int wc, int fr, int fq, LAS unsigned char*) const {
        const int row0 = u.pm * BM + wr * 64 + fr, col0 = u.pn * BM + wc * 32 + 8 * fq;
#pragma unroll
        for (int ai = 0; ai < 2; ++ai)
#pragma unroll
            for (int m = 0; m < 4; ++m) { bf16_t* rowp = O + (size_t)(row0 + ai * HALF + m * 16) * ldc + col0;
#pragma unroll
                for (int bj = 0; bj < 2; ++bj) store8(rowp + bj * HALF, acc[ai][bj][m][0], acc[ai][bj][m][1]); }
    }
};
struct EpiInProj {
    bf16_t* UA; bf16_t* QKV; float qscale;
    __device__ __forceinline__ void operator()(f32x4 (&acc)[2][2][4][2], const Unit& u, int wr, int wc, int fr, int fq, LAS unsigned char*) const {
        const int colt = u.pn * BM + wc * 32 + 8 * fq;
        const float sc = (u.pn >= 2 && u.pn < 4) ? qscale : 1.0f;
#pragma unroll
        for (int ai = 0; ai < 2; ++ai)
#pragma unroll
            for (int m = 0; m < 4; ++m) { const int rowg = u.pm * BM + ai * HALF + wr * 64 + m * 16 + fr;
#pragma unroll
                for (int bj = 0; bj < 2; ++bj) { const int colg = colt + bj * HALF; bf16_t* dst;
                    if (u.pn < 2) { const int g = colg >> 4, c = colg & 15, b = rowg >> 12, t = rowg & 4095; dst = UA + ((size_t)(g * 2048 + b * 256 + (t >> 4)) * 384 + (t & 15) * 16 + c); }
                    else dst = QKV + (size_t)rowg * 1536 + (colg - 512);
                    store8(dst, acc[ai][bj][m][0] * sc, acc[ai][bj][m][1] * sc); } }
    }
};
struct EpiS1 {
    float* S;
    __device__ __forceinline__ void operator()(f32x4 (&acc)[2][2][4][2], const Unit& u, int wr, int wc, int fr, int fq, LAS unsigned char*) const {
        const int col = wc * 32 + 8 * fq;
#pragma unroll
        for (int ai = 0; ai < 2; ++ai)
#pragma unroll
            for (int m = 0; m < 4; ++m) { const int r = ai * HALF + wr * 64 + m * 16 + fr; float* dst = S + ((size_t)(u.z * 2048 + u.pm * 256 + r) * 128 + col);
                *(f32x4*)dst = acc[ai][0][m][0]; *(f32x4*)(dst + 4) = acc[ai][0][m][1]; }
    }
};
struct EpiS3 {
    bf16_t* Gb;
    __device__ __forceinline__ void operator()(f32x4 (&acc)[2][2][4][2], const Unit& u, int wr, int wc, int fr, int fq, LAS unsigned char*) const {
#pragma unroll
        for (int ai = 0; ai < 2; ++ai)
#pragma unroll
            for (int m = 0; m < 4; ++m) { const int k = ai * HALF + wr * 64 + m * 16 + fr;
#pragma unroll
                for (int bj = 0; bj < 2; ++bj) { const int col = bj * HALF + wc * 32 + 8 * fq, j = col >> 4, o = col & 15;
                    const size_t tok = (size_t)u.pm * 4096 + 16 * k + j; f32x4 v0 = acc[ai][bj][m][0], v1 = acc[ai][bj][m][1];
#pragma unroll
                    for (int e = 0; e < 4; ++e) { v0[e] = gelu_tanh(v0[e]); v1[e] = gelu_tanh(v1[e]); }
                    store8(Gb + tok * 512 + 16 * u.z + o, v0, v1); asm volatile("" ::: "memory"); } }
    }
};
struct EpiGlu {
    const bf16_t* Gb; const float* bias; bf16_t* Y;
    __device__ __forceinline__ void operator()(f32x4 (&acc)[2][2][4][2], const Unit& u, int wr, int wc, int fr, int fq, LAS unsigned char*) const {
        const int col0 = u.pn * BM + wc * 32 + 8 * fq;
#pragma unroll
        for (int bj = 0; bj < 2; ++bj) { const int col = col0 + bj * HALF; const f32x4 b0 = *(const f32x4*)(bias + col), b1 = *(const f32x4*)(bias + col + 4);
#pragma unroll
            for (int ai = 0; ai < 2; ++ai)
#pragma unroll
                for (int m = 0; m < 4; ++m) { const size_t row = (size_t)u.pm * BM + ai * HALF + wr * 64 + m * 16 + fr;
                    const u32x4 gw = *(const u32x4*)(Gb + row * 512 + col);
                    f32x4 z0 = acc[ai][bj][m][0] + b0, z1 = acc[ai][bj][m][1] + b1, o0, o1;
                    o0[0] = bf_lo(gw.x) * fsigmoid(z0[0]); o0[1] = bf_hi(gw.x) * fsigmoid(z0[1]); o0[2] = bf_lo(gw.y) * fsigmoid(z0[2]); o0[3] = bf_hi(gw.y) * fsigmoid(z0[3]);
                    o1[0] = bf_lo(gw.z) * fsigmoid(z1[0]); o1[1] = bf_hi(gw.z) * fsigmoid(z1[1]); o1[2] = bf_lo(gw.w) * fsigmoid(z1[2]); o1[3] = bf_hi(gw.w) * fsigmoid(z1[3]);
                    store8(Y + row * 1024 + col, o0, o1); } }
    }
};
struct EpiSwiglu {
    bf16_t* O; int ldc;
    __device__ __forceinline__ void operator()(f32x4 (&acc)[2][2][4][2], const Unit& u, int wr, int wc, int fr, int fq, LAS unsigned char*) const {
        const int col = u.pn * HALF + wc * 32 + 8 * fq;
#pragma unroll
        for (int ai = 0; ai < 2; ++ai)
#pragma unroll
            for (int m = 0; m < 4; ++m) { const size_t row = (size_t)u.pm * BM + ai * HALF + wr * 64 + m * 16 + fr; f32x4 o0, o1;
#pragma unroll
                for (int e = 0; e < 4; ++e) { const float g0 = acc[ai][0][m][0][e], g1 = acc[ai][0][m][1][e]; o0[e] = g0 * fsigmoid(g0) * acc[ai][1][m][0][e]; o1[e] = g1 * fsigmoid(g1) * acc[ai][1][m][1][e]; }
                store8(O + row * ldc + col, o0, o1); }
    }
};
struct EpiSoftmax {
    bf16_t* O; int ldc; float sc2;
    __device__ __forceinline__ void operator()(f32x4 (&acc)[2][2][4][2], const Unit& u, int wr, int wc, int fr, int fq, LAS unsigned char* scr) const {
        LAS float* Pm = (LAS float*)scr; LAS float* Ps = (LAS float*)(scr + 4096);
#pragma unroll
        for (int ai = 0; ai < 2; ++ai)
#pragma unroll
            for (int m = 0; m < 4; ++m) { float mx = -INFINITY;
#pragma unroll
                for (int bj = 0; bj < 2; ++bj)
#pragma unroll
                    for (int n = 0; n < 2; ++n) { const f32x4 x = acc[ai][bj][m][n]; mx = fmaxf(mx, fmaxf(fmaxf(x[0], x[1]), fmaxf(x[2], x[3]))); }
                mx = fmaxf(mx, __shfl_xor(mx, 16)); mx = fmaxf(mx, __shfl_xor(mx, 32));
                if (fq == 0) Pm[(ai * HALF + wr * 64 + m * 16 + fr) * 4 + wc] = mx; asm volatile("" ::: "memory"); }
        asm volatile("s_waitcnt lgkmcnt(0)" ::: "memory"); __builtin_amdgcn_s_barrier(); asm volatile("" ::: "memory");
#pragma unroll
        for (int ai = 0; ai < 2; ++ai)
#pragma unroll
            for (int m = 0; m < 4; ++m) { const int r = ai * HALF + wr * 64 + m * 16 + fr; const f32x4 pm4 = *(const LAS f32x4*)(Pm + r * 4);
                const float mx = fmaxf(fmaxf(pm4[0], pm4[1]), fmaxf(pm4[2], pm4[3])); float s = 0.f;
#pragma unroll
                for (int bj = 0; bj < 2; ++bj)
#pragma unroll
                    for (int n = 0; n < 2; ++n) { f32x4 x = acc[ai][bj][m][n];
#pragma unroll
                        for (int e = 0; e < 4; ++e) { x[e] = __builtin_amdgcn_exp2f((x[e] - mx) * sc2); s += x[e]; }
                        acc[ai][bj][m][n] = x; }
                s += __shfl_xor(s, 16); s += __shfl_xor(s, 32);
                if (fq == 0) Ps[r * 4 + wc] = s; asm volatile("" ::: "memory"); }
        asm volatile("s_waitcnt lgkmcnt(0)" ::: "memory"); __builtin_amdgcn_s_barrier(); asm volatile("" ::: "memory");
        const int col0 = u.pn * BM + wc * 32 + 8 * fq;
#pragma unroll
        for (int ai = 0; ai < 2; ++ai)
#pragma unroll
            for (int m = 0; m < 4; ++m) { const int r = ai * HALF + wr * 64 + m * 16 + fr; const f32x4 ps4 = *(const LAS f32x4*)(Ps + r * 4);
                const float inv = 1.0f / ((ps4[0] + ps4[1]) + (ps4[2] + ps4[3])); bf16_t* rowp = O + (size_t)(u.pm * BM + r) * ldc + col0;
#pragma unroll
                for (int bj = 0; bj < 2; ++bj) store8(rowp + bj * HALF, acc[ai][bj][m][0] * inv, acc[ai][bj][m][1] * inv); asm volatile("" ::: "memory"); }
        asm volatile("s_waitcnt lgkmcnt(0)" ::: "memory"); __builtin_amdgcn_s_barrier(); asm volatile("" ::: "memory");
    }
};

template <class Epi, class SchedT, bool ALIGN_EPI>
__device__ __forceinline__ void gemm_phase(LAS unsigned char* lds, const Gemm g, const SchedT& S, const Epi& E, LAS unsigned char* scr) {
    int tid = threadIdx.x; asm volatile("" : "+v"(tid));
    const int wid = __builtin_amdgcn_readfirstlane(tid >> 6), lane = tid & 63, wr = wid >> 2, wc = wid & 3, fr = lane & 15, fq = lane >> 4;
    const int K = g.K, nt = K / BK;
    unsigned voffA[2], voffB[2];
#pragma unroll
    for (int i = 0; i < 2; ++i) { int R, C; stage_rc(tid * 16 + i * 8192, R, C); const int Rb = (R & ~31) + perm32(R & 31);
        voffA[i] = (unsigned)(R * g.lda + C) * 2u; voffB[i] = (unsigned)(Rb * g.ldb + C) * 2u; }
    const size_t kstep = (size_t)(BK * 2);
    const size_t hstepA = (size_t)HALF * g.lda * 2, hstepB = (size_t)HALF * g.ldb * 2;
    const unsigned ldsw = (unsigned)wid * 1024u;
    const int aoff = lds_byte(wr * 64 + fr, fq * 8), boff = lds_byte(wc * 32 + fr, fq * 8);
#define PG8_SA(b, h) (((b) * 2 + (h)) * HTB)
#define PG8_SB(b, h) ((4 + (b) * 2 + (h)) * HTB)
#define PG8_STAGE(bufoff, gbase, voff) do { _Pragma("unroll") for (int _i = 0; _i < 2; ++_i) \
        __builtin_amdgcn_global_load_lds((const unsigned*)((const char*)(gbase) + (voff)[_i]), (LAS unsigned*)(lds + (bufoff) + ldsw + _i * 8192), 16, 0, 0); } while (0)
#define PG8_LDA(dst, b, h) do { _Pragma("unroll") for (int m = 0; m < 4; ++m) _Pragma("unroll") for (int k = 0; k < 2; ++k) dst[m][k] = *(const LAS bf16x8*)(lds + PG8_SA(b, h) + aoff + m * 2048 + k * 1024); } while (0)
#define PG8_LDB(dst, b, h) do { _Pragma("unroll") for (int n = 0; n < 2; ++n) _Pragma("unroll") for (int k = 0; k < 2; ++k) dst[n][k] = *(const LAS bf16x8*)(lds + PG8_SB(b, h) + boff + n * 2048 + k * 1024); } while (0)
#define PG8_MMA(ai, bj, At, Bt) do { __builtin_amdgcn_s_setprio(1); _Pragma("unroll") for (int m = 0; m < 4; ++m) _Pragma("unroll") for (int n = 0; n < 2; ++n) _Pragma("unroll") for (int k = 0; k < 2; ++k) \
        acc[ai][bj][m][n] = __builtin_amdgcn_mfma_f32_16x16x32_bf16(Bt[n][k], At[m][k], acc[ai][bj][m][n], 0, 0, 0); __builtin_amdgcn_s_setprio(0); } while (0)
#define PG8_WAIT_V(n) asm volatile("s_waitcnt vmcnt(" #n ")" ::: "memory")
#define PG8_WAIT_L(n) asm volatile("s_waitcnt lgkmcnt(" #n ")" ::: "memory")
#define PG8_BAR __builtin_amdgcn_s_barrier()
#define PG8_SCHED __builtin_amdgcn_sched_barrier(0)
    Unit cur, nxt; int ui = 0;
    if (!S.next(0, cur)) return;
    f32x4 acc[2][2][4][2];
#pragma unroll
    for (int a = 0; a < 2; ++a)
#pragma unroll
        for (int b = 0; b < 2; ++b)
#pragma unroll
            for (int m = 0; m < 4; ++m)
#pragma unroll
                for (int n = 0; n < 2; ++n) acc[a][b][m][n] = (f32x4){0.f, 0.f, 0.f, 0.f};
    bf16x8 At[4][2], B0[2][2], B1[2][2];
    const char* cA = cur.a; const char* cB = cur.b;
    PG8_STAGE(PG8_SB(0, 0), cB, voffB); PG8_STAGE(PG8_SB(0, 1), cB + hstepB, voffB); PG8_STAGE(PG8_SA(0, 0), cA, voffA); PG8_STAGE(PG8_SA(0, 1), cA + hstepA, voffA);
    if (wr == 1) PG8_BAR;
    PG8_WAIT_V(2); PG8_BAR;
    PG8_STAGE(PG8_SB(1, 0), cB + kstep, voffB); PG8_STAGE(PG8_SA(1, 0), cA + kstep, voffA); PG8_STAGE(PG8_SB(1, 1), cB + hstepB + kstep, voffB);
    PG8_WAIT_V(6); PG8_BAR;
    for (;;) {
        const bool has_next = S.next(ui + 1, nxt);
        const char* nA = has_next ? nxt.a : cA; const char* nB = has_next ? nxt.b : cB;
        for (int t = 0; t < nt; t += 2) {
            const bool last = (t == nt - 2);
            const char* a1 = cA + (size_t)(t + 1) * kstep;
            const char* a2 = last ? nA : cA + (size_t)(t + 2) * kstep; const char* b2 = last ? nB : cB + (size_t)(t + 2) * kstep;
            const char* a3 = a2 + kstep; const char* b3 = b2 + kstep;
            PG8_LDB(B0, 0, 0); PG8_LDB(B1, 0, 1); PG8_SCHED; PG8_LDA(At, 0, 0); PG8_STAGE(PG8_SA(1, 1), a1 + hstepA, voffA);
            PG8_WAIT_V(8); PG8_WAIT_L(0); PG8_BAR; PG8_MMA(0, 0, At, B0); PG8_MMA(0, 1, At, B1); PG8_BAR; PG8_SCHED;
            PG8_LDA(At, 0, 1); PG8_STAGE(PG8_SB(0, 0), b2, voffB); PG8_STAGE(PG8_SB(0, 1), b2 + hstepB, voffB); PG8_STAGE(PG8_SA(0, 0), a2, voffA);
            PG8_WAIT_V(8); PG8_WAIT_L(0); PG8_BAR; PG8_MMA(1, 0, At, B0); PG8_MMA(1, 1, At, B1); PG8_BAR; PG8_SCHED;
            PG8_LDB(B0, 1, 0); PG8_LDB(B1, 1, 1); PG8_SCHED; PG8_LDA(At, 1, 0); PG8_STAGE(PG8_SA(0, 1), a2 + hstepA, voffA);
            PG8_WAIT_V(8); PG8_WAIT_L(0); PG8_BAR; PG8_MMA(0, 0, At, B0); PG8_MMA(0, 1, At, B1); PG8_BAR; PG8_SCHED;
            PG8_LDA(At, 1, 1); PG8_STAGE(PG8_SB(1, 0), b3, voffB); PG8_STAGE(PG8_SB(1, 1), b3 + hstepB, voffB); PG8_STAGE(PG8_SA(1, 0), a3, voffA);
            PG8_WAIT_V(8); PG8_WAIT_L(0); PG8_BAR; PG8_MMA(1, 0, At, B0); PG8_MMA(1, 1, At, B1); PG8_BAR; PG8_SCHED;
        }
        if constexpr (ALIGN_EPI) { if (wr == 0) PG8_BAR; }
        { int fr2 = fr, fq2 = fq; asm volatile("" : "+v"(fr2), "+v"(fq2)); E(acc, cur, wr, wc, fr2, fq2, scr); }
        if (!has_next) break;
#pragma unroll
        for (int a = 0; a < 2; ++a)
#pragma unroll
            for (int b = 0; b < 2; ++b)
#pragma unroll
                for (int m = 0; m < 4; ++m)
#pragma unroll
                    for (int n = 0; n < 2; ++n) acc[a][b][m][n] = (f32x4){0.f, 0.f, 0.f, 0.f};
        cur = nxt; cA = nA; cB = nB; ++ui;
        if constexpr (ALIGN_EPI) { if (wr == 1) PG8_BAR; }
    }
    PG8_WAIT_V(0);
    if constexpr (!ALIGN_EPI) { if (wr == 0) PG8_BAR; }
    PG8_BAR;
#undef PG8_SA
#undef PG8_SB
#undef PG8_STAGE
#undef PG8_LDA
#undef PG8_LDB
#undef PG8_MMA
#undef PG8_WAIT_V
#undef PG8_WAIT_L
#undef PG8_BAR
#undef PG8_SCHED
}
}

namespace attn_body {
using bf16=__hip_bfloat16;
using bf16x8=__attribute__((ext_vector_type(8)))short;
using s16x4=__attribute__((ext_vector_type(4)))short;
using f32x16=__attribute__((ext_vector_type(16)))float;
using f32x4=__attribute__((ext_vector_type(4)))float;
using u32x4=__attribute__((ext_vector_type(4)))unsigned;
constexpr int BATCH=8,NHEAD=8,SEQ=4096,D=64,DM=1536,OP=1024;
constexpr int NW=8,QBLK=32,QB=QBLK*NW,KVBLK=64,NQB=SEQ/QB;
__device__ __forceinline__ int crow(int r,int hi){return (r&3)+8*(r>>2)+4*hi;}
#define SBAR() __builtin_amdgcn_sched_barrier(0)
__device__ __forceinline__ void cmask(f32x16&p0,f32x16&p1,int jb,int qrel,int hi){
  asm volatile("":"+v"(hi),"+v"(qrel));
  const float NEG=-INFINITY; int kb=64*jb+4*hi;
  #pragma unroll
  for(int r=0;r<16;++r){int kv=kb+(r&3)+8*(r>>2); if(kv>qrel)p0[r]=NEG; if(kv+32>qrel)p1[r]=NEG;}
}
constexpr int NSLOT=3, SLOTB=8192;
constexpr int LDS_K=0, LDS_V=NSLOT*SLOTB, LDS_WS=2*NSLOT*SLOTB, LDS_OST=LDS_WS+NW*64*4, LDS_F=LDS_OST+NW*4096, LDS_BYTES=LDS_F+SEQ*4;
constexpr float C2=0.125f*1.4426950408889634f;
__device__ __forceinline__ void glds16(const void*sbase,unsigned voff,unsigned lds_dst){unsigned keep;
  asm volatile("s_mov_b32 %0, m0\n\ts_mov_b32 m0, %3\n\ts_nop 0\n\tglobal_load_lds_dwordx4 %1, %2\n\ts_mov_b32 m0, %0":"=&s"(keep):"v"(voff),"s"(sbase),"s"(lds_dst):"memory");}
__device__ __forceinline__ float max3f(float a,float b,float c){float r;asm("v_max3_f32 %0, %1, %2, %3":"=v"(r):"v"(a),"v"(b),"v"(c));return r;}
__device__ __forceinline__ float max2f(float a,float b){float r;asm("v_max_f32_e32 %0, %1, %2":"=v"(r):"v"(a),"v"(b));return r;}
__device__ __forceinline__ float fadd_s(float a,float b){float r;asm("v_add_f32_e32 %0, %1, %2":"=v"(r):"v"(a),"v"(b));return r;}
__device__ __forceinline__ float fsub_s(float a,float b){float r;asm("v_sub_f32_e32 %0, %1, %2":"=v"(r):"v"(a),"v"(b));return r;}
typedef float f32x2_t __attribute__((ext_vector_type(2))); typedef __bf16 bf16x2_t __attribute__((ext_vector_type(2)));
__device__ __forceinline__ unsigned cvtpk_s(float lo,float hi){f32x2_t v={lo,hi};bf16x2_t b=__builtin_convertvector(v,bf16x2_t);return __builtin_bit_cast(unsigned,b);}
#define WAIT_BAR(N) asm volatile("s_waitcnt vmcnt(" #N ") lgkmcnt(0)\n\ts_barrier":::"memory")
__device__ __forceinline__ void qkt(f32x16&p0,f32x16&p1,const char*Kslot,const bf16x8*qr,const f32x16&negm,int r32,int hi){
  const char*kb=Kslot+hi*1024+r32*16;
  #pragma unroll
  for(int d0=0;d0<4;++d0){
    const bf16x8 b0=*reinterpret_cast<const bf16x8*>(kb+d0*2048);
    const bf16x8 b1=*reinterpret_cast<const bf16x8*>(kb+d0*2048+512);
    if(d0==0){p0=__builtin_amdgcn_mfma_f32_32x32x16_bf16(b0,qr[0],negm,0,0,0);p1=__builtin_amdgcn_mfma_f32_32x32x16_bf16(b1,qr[0],negm,0,0,0);}
    else{p0=__builtin_amdgcn_mfma_f32_32x32x16_bf16(b0,qr[d0],p0,0,0,0);p1=__builtin_amdgcn_mfma_f32_32x32x16_bf16(b1,qr[d0],p1,0,0,0);}}
}
typedef __attribute__((address_space(3))) const char* lds_cptr;
typedef short v4i16_t __attribute__((ext_vector_type(4)));
__device__ __forceinline__ void kload8(bf16x8*kf,lds_cptr kp){
  kf[0]=*(const __attribute__((address_space(3))) bf16x8*)(kp);      kf[1]=*(const __attribute__((address_space(3))) bf16x8*)(kp+512);
  kf[2]=*(const __attribute__((address_space(3))) bf16x8*)(kp+2048); kf[3]=*(const __attribute__((address_space(3))) bf16x8*)(kp+2560);
  kf[4]=*(const __attribute__((address_space(3))) bf16x8*)(kp+4096); kf[5]=*(const __attribute__((address_space(3))) bf16x8*)(kp+4608);
  kf[6]=*(const __attribute__((address_space(3))) bf16x8*)(kp+6144); kf[7]=*(const __attribute__((address_space(3))) bf16x8*)(kp+6656);
}
__device__ __forceinline__ void kload2(bf16x8*kf,lds_cptr kp,int j){ kf[2*j]=*(const __attribute__((address_space(3))) bf16x8*)(kp+j*2048); kf[2*j+1]=*(const __attribute__((address_space(3))) bf16x8*)(kp+j*2048+512); }
__device__ __forceinline__ s16x4 vtr(lds_cptr p){ return __builtin_bit_cast(s16x4,__builtin_amdgcn_ds_read_tr16_b64_v4i16((__attribute__((address_space(3))) v4i16_t*)p)); }
__device__ __forceinline__ float rowmax(const f32x16&p0,const f32x16&p1){
  float a=max3f(p0[0],p0[1],p1[0]),b=max3f(p0[2],p0[3],p1[1]);a=max3f(a,p1[2],p1[3]);
  #pragma unroll
  for(int r=4;r<16;r+=4){a=max3f(a,p0[r],p0[r+1]);b=max3f(b,p0[r+2],p0[r+3]);a=max3f(a,p1[r],p1[r+1]);b=max3f(b,p1[r+2],p1[r+3]);}
  const float m=max2f(a,b);
  auto rr=__builtin_amdgcn_permlane32_swap(__float_as_uint(m),__float_as_uint(m),false,false);
  return max2f(__uint_as_float(rr[0]),__uint_as_float(rr[1]));
}
__device__ __forceinline__ void pv(f32x16*o,int vb,bf16x8 pa0,bf16x8 pa1,bf16x8 pa2,bf16x8 pa3){
  #pragma unroll
  for(int d0=0;d0<2;++d0){s16x4 lo[4],hi[4];
    #pragma unroll
    for(int ks=0;ks<4;++ks){
      asm volatile("ds_read_b64_tr_b16 %0,%1 offset:%c2":"=&v"(lo[ks]):"v"(vb),"i"(d0*4096+ks*1024):"memory");
      asm volatile("ds_read_b64_tr_b16 %0,%1 offset:%c2":"=&v"(hi[ks]):"v"(vb),"i"(d0*4096+ks*1024+512):"memory");}
    asm volatile("s_waitcnt lgkmcnt(0)":::"memory");SBAR();
    #define PK(k) (bf16x8){lo[k][0],lo[k][1],lo[k][2],lo[k][3],hi[k][0],hi[k][1],hi[k][2],hi[k][3]}
    o[d0]=__builtin_amdgcn_mfma_f32_32x32x16_bf16(pa0,PK(0),o[d0],0,0,0);
    o[d0]=__builtin_amdgcn_mfma_f32_32x32x16_bf16(pa1,PK(1),o[d0],0,0,0);
    o[d0]=__builtin_amdgcn_mfma_f32_32x32x16_bf16(pa2,PK(2),o[d0],0,0,0);
    o[d0]=__builtin_amdgcn_mfma_f32_32x32x16_bf16(pa3,PK(3),o[d0],0,0,0);
    #undef PK
  }
}
#define ATTN_STORE16(p,v) (*(u32x4*)(p)=(v))
template<int THRL> __device__ __forceinline__ void attn_unit(int b,int h,int qb,const bf16*Q,const bf16*__restrict__ K,const bf16*__restrict__ V,bf16*O,const float*__restrict__ Fc,char*shm){
  int tid=threadIdx.x; asm volatile("":"+v"(tid));
  const int lane=tid&63,r32=lane&31,hi=lane>>5; const int wid=__builtin_amdgcn_readfirstlane(tid>>6);
  const long rowbase=(long)b*SEQ; const int q0=qb*QB;
  const bf16*Qw=Q+(rowbase+q0+wid*QBLK)*DM+h*D;
  const bf16*Kh=K+rowbase*DM+h*D,*Vh=V+rowbase*DM+h*D;
  const unsigned lds0=(unsigned)(uintptr_t)shm;
  float*wsf=(float*)(shm+LDS_WS)+wid*64;
  const lds_cptr shm3=(lds_cptr)shm;
  const int NT=(q0+QB)/KVBLK;
  const float*Fg=Fc+(long)(b*NHEAD+h)*SEQ;
  { __attribute__((address_space(3))) float* fl=(__attribute__((address_space(3))) float*)(shm3+LDS_F);
    for(int i=tid*4;i<NT*KVBLK;i+=NW*64*4){ const f32x4 v=*(const f32x4*)(Fg+i); *(__attribute__((address_space(3))) f32x4*)(fl+i)=v; } }
  const float frow=Fg[q0+wid*QBLK+r32];
  asm volatile("s_waitcnt vmcnt(0)":::"memory");
  const unsigned koff=(unsigned)(lane*DM+wid*8)*2u;
  const unsigned voff=(unsigned)((16*(wid&3)+(lane>>2))*DM+(wid>>2)*32+(lane&3)*8)*2u;
  const unsigned kdst=lds0+LDS_K+wid*1024, vdst=lds0+LDS_V+wid*1024;
  #define DMA_K(t,slot) glds16(Kh+(long)(t)*KVBLK*DM,koff,(unsigned)__builtin_amdgcn_readfirstlane(kdst+(slot)))
  #define DMA_V(t,slot) glds16(Vh+(long)(t)*KVBLK*DM,voff,(unsigned)__builtin_amdgcn_readfirstlane(vdst+(slot)))
  const char*Kbase=shm+LDS_K; bf16x8 kf[8];
  const lds_cptr kp0=shm3+LDS_K+hi*1024+r32*16; const lds_cptr vp0=shm3+LDS_V+((lane>>4)&1)*32+(lane&3)*8+(4*hi+((lane&15)>>2))*64;
  const lds_cptr fp0=shm3+LDS_F+16*hi;
  DMA_K(0,0);DMA_V(0,0);DMA_K(1,SLOTB);
  bf16x8 qr[4];
  #pragma unroll
  for(int d0=0;d0<4;++d0)qr[d0]=*reinterpret_cast<const bf16x8*>(&Qw[(long)r32*DM+d0*16+hi*8]);
  float mhat=0.f,l_reg=0.f;f32x16 o[2];o[0]=f32x16{};o[1]=f32x16{};const f32x16 negm=f32x16{};float rb=frow;
  const int qrel=wid*QBLK+r32;
  #define CMASK(P0,P1,t) do{int jb_=(t)-(NT-4); if(jb_>=0)cmask(P0,P1,jb_,qrel,hi);}while(0)
  #define KBIAS(P0,P1,t) do{ const lds_cptr fp_=fp0+(t)*256; \
    _Pragma("unroll") for(int j_=0;j_<4;++j_){ const f32x4 a_=*(const __attribute__((address_space(3))) f32x4*)(fp_+j_*32); \
      P0[4*j_]+=rb-a_[0];P0[4*j_+1]+=rb-a_[1];P0[4*j_+2]+=rb-a_[2];P0[4*j_+3]+=rb-a_[3]; } SBAR(); \
    _Pragma("unroll") for(int j_=0;j_<4;++j_){ const f32x4 b_=*(const __attribute__((address_space(3))) f32x4*)(fp_+128+j_*32); \
      P1[4*j_]+=rb-b_[0];P1[4*j_+1]+=rb-b_[1];P1[4*j_+2]+=rb-b_[2];P1[4*j_+3]+=rb-b_[3]; } SBAR(); }while(0)
  bool resc=false;
  #define START(P0,P1) do{ const float rm=rowmax(P0,P1); resc=false; \
    { const float dl=__builtin_fmaxf(rm,0.f); mhat=fadd_s(mhat,dl); \
      _Pragma("unroll") for(int r=0;r<16;++r){P0[r]=fsub_s(P0[r],dl);P1[r]=fsub_s(P1[r],dl);} \
      rb=frow-mhat; } \
    _Pragma("unroll") for(int r=0;r<16;++r)P0[r]=__builtin_amdgcn_exp2f(P0[r]); }while(0)
  #define RESC() do{ if(resc){ asm volatile("s_waitcnt lgkmcnt(0)":::"memory"); \
      _Pragma("unroll") for(int d_=0;d_<2;++d_) _Pragma("unroll") for(int r=0;r<16;++r)o[d_][r]*=wsf[crow(r,hi)]; } }while(0)
  f32x16 pA0,pA1,pB0,pB1;
  int sl_prev=0,sl_cur=0,sl_next=SLOTB;
  #define ROT() do{sl_prev=sl_cur;sl_cur=sl_next;sl_next=(sl_next==(NSLOT-1)*SLOTB)?0:sl_next+SLOTB;}while(0)
  DMA_K(2,2*SLOTB);
  WAIT_BAR(3);
  qkt(pA0,pA1,Kbase,qr,negm,r32,hi);asm volatile("s_nop 15\n\ts_nop 7":"+v"(pA0),"+v"(pA1));KBIAS(pA0,pA1,0);CMASK(pA0,pA1,0);
  START(pA0,pA1);
  _Pragma("unroll") for(int r=0;r<16;++r)pA1[r]=__builtin_amdgcn_exp2f(pA1[r]);
  WAIT_BAR(0);
  DMA_K(3,0);DMA_V(1,SLOTB);
  ROT();
  kload8(kf,kp0+sl_cur);
  WAIT_BAR(2);
  s16x4 vlo[8],vhi[8]; u32x4 pw0,pw1,pw2,pw3;
  #define PKW(P,B) cvtpk_s(P[B],P[B+1])
  #define PAF(k) __builtin_bit_cast(bf16x8,pw##k)
  #define VFR(i) (bf16x8){vlo[i][0],vlo[i][1],vlo[i][2],vlo[i][3],vhi[i][0],vhi[i][1],vhi[i][2],vhi[i][3]}
  #define PIN(x) asm volatile("":"+v"(x))
  #define MX3(a,b,c) __builtin_fmaxf(__builtin_fmaxf((a),(b)),(c))
  #define GAPA(MF,A0,A1,A2,A3,W0,W1,PW) do{ MF; sacc+=A0; sacc+=A1; sacc+=A2; sacc+=A3; PIN(sacc); W0; W1; PIN(PW); SBAR(); }while(0)
  #define EX(v) __builtin_amdgcn_exp2f(v)
  #define GAPB(MF,X,B) do{ MF; X[B]=EX(X[B]); X[B+1]=EX(X[B+1]); X[B+2]=EX(X[B+2]); X[B+3]=EX(X[B+3]); PIN(X); SBAR(); }while(0)
  #define VRD(i) do{ vlo[i]=vtr(vp_+(((i)>>2)*4096+((i)&3)*1024)); vhi[i]=vtr(vp_+(((i)>>2)*4096+((i)&3)*1024+512)); }while(0)
  #define KRD(G,j) do{ if(G){ kload2(kf,kp0+sl_next,j); SBAR(); } }while(0)
  #define STEP(C0,C1,P0,P1,t,GK,GV,GL) do{ SBAR(); \
    const lds_cptr vp_=vp0+sl_prev; \
    VRD(0); SBAR(); float sacc=(P0[0]+P0[1]); \
    GAPA(C0=__builtin_amdgcn_mfma_f32_32x32x16_bf16(kf[0],qr[0],negm,0,0,0), P0[2],P0[3],P0[4],P0[5],     pw0[0]=PKW(P0,0), pw0[1]=PKW(P0,2), pw0); \
    VRD(4); SBAR(); GAPA(C1=__builtin_amdgcn_mfma_f32_32x32x16_bf16(kf[1],qr[0],negm,0,0,0), P0[6],P0[7],P0[8],P0[9],     pw0[2]=PKW(P0,4), pw0[3]=PKW(P0,6), pw0); \
    VRD(1); SBAR(); GAPA(C0=__builtin_amdgcn_mfma_f32_32x32x16_bf16(kf[2],qr[1],C0,0,0,0),   P0[10],P0[11],P0[12],P0[13], pw1[0]=PKW(P0,8), pw1[1]=PKW(P0,10), pw1); \
    VRD(5); SBAR(); GAPA(C1=__builtin_amdgcn_mfma_f32_32x32x16_bf16(kf[3],qr[1],C1,0,0,0),   P0[14],P0[15],P1[0],P1[1],   pw1[2]=PKW(P0,12),pw1[3]=PKW(P0,14), pw1); \
    VRD(2); SBAR(); GAPA(C0=__builtin_amdgcn_mfma_f32_32x32x16_bf16(kf[4],qr[2],C0,0,0,0),   P1[2],P1[3],P1[4],P1[5],     pw2[0]=PKW(P1,0), pw2[1]=PKW(P1,2), pw2); \
    VRD(6); SBAR(); GAPA(C1=__builtin_amdgcn_mfma_f32_32x32x16_bf16(kf[5],qr[2],C1,0,0,0),   P1[6],P1[7],P1[8],P1[9],     pw2[2]=PKW(P1,4), pw2[3]=PKW(P1,6), pw2); \
    VRD(3); SBAR(); GAPA(C0=__builtin_amdgcn_mfma_f32_32x32x16_bf16(kf[6],qr[3],C0,0,0,0),   P1[10],P1[11],P1[12],P1[13], pw3[0]=PKW(P1,8), pw3[1]=PKW(P1,10), pw3); \
    VRD(7); SBAR(); GAPA(C1=__builtin_amdgcn_mfma_f32_32x32x16_bf16(kf[7],qr[3],C1,0,0,0),   P1[14],P1[15],0.f,0.f,       pw3[2]=PKW(P1,12),pw3[3]=PKW(P1,14), pw3); \
    l_reg+=sacc; \
    if(GK){DMA_K((t)+3,sl_cur);} if(GV){DMA_V((t)+1,sl_next);} \
    KBIAS(C0,C1,t); \
    CMASK(C0,C1,t); \
    { float a=MX3(C0[0],C0[1],C1[0]),b=MX3(C0[2],C0[3],C1[1]); a=MX3(a,C1[2],C1[3]); \
      _Pragma("unroll") for(int r=4;r<16;r+=4){a=MX3(a,C0[r],C0[r+1]);b=MX3(b,C0[r+2],C0[r+3]);a=MX3(a,C1[r],C1[r+1]);b=MX3(b,C1[r+2],C1[r+3]);} \
      float rm=__builtin_fmaxf(a,b); { auto rr=__builtin_amdgcn_permlane32_swap(__float_as_uint(rm),__float_as_uint(rm),false,false); rm=__builtin_fmaxf(__uint_as_float(rr[0]),__uint_as_float(rr[1])); } \
      resc=false; \
      if(__builtin_expect(__any(rm>(float)THRL),0)){ const float dl=__builtin_fmaxf(rm,0.f); mhat+=dl; \
        _Pragma("unroll") for(int r=0;r<16;++r){C0[r]-=dl;C1[r]-=dl;} \
        rb=frow-mhat; \
        const float f=__builtin_amdgcn_exp2f(-dl); l_reg*=f; if(hi==0)wsf[r32]=f; resc=true; } } \
    SBAR(); \
    GAPB(o[0]=__builtin_amdgcn_mfma_f32_32x32x16_bf16(PAF(0),VFR(0),o[0],0,0,0), C0,0); \
    GAPB(o[1]=__builtin_amdgcn_mfma_f32_32x32x16_bf16(PAF(0),VFR(4),o[1],0,0,0), C0,4); \
    KRD(GL,0); GAPB(o[0]=__builtin_amdgcn_mfma_f32_32x32x16_bf16(PAF(1),VFR(1),o[0],0,0,0), C0,8); \
    KRD(GL,1); GAPB(o[1]=__builtin_amdgcn_mfma_f32_32x32x16_bf16(PAF(1),VFR(5),o[1],0,0,0), C0,12); \
    KRD(GL,2); GAPB(o[0]=__builtin_amdgcn_mfma_f32_32x32x16_bf16(PAF(2),VFR(2),o[0],0,0,0), C1,0); \
    KRD(GL,3); GAPB(o[1]=__builtin_amdgcn_mfma_f32_32x32x16_bf16(PAF(2),VFR(6),o[1],0,0,0), C1,4); \
    GAPB(o[0]=__builtin_amdgcn_mfma_f32_32x32x16_bf16(PAF(3),VFR(3),o[0],0,0,0), C1,8); \
    GAPB(o[1]=__builtin_amdgcn_mfma_f32_32x32x16_bf16(PAF(3),VFR(7),o[1],0,0,0), C1,12); \
    }while(0)
  int t=1;
  #undef CMASK
  #define CMASK(P0,P1,t) do{}while(0)
  for(;t+5<NT;t+=2){
    STEP(pB0,pB1,pA0,pA1,t,true,true,true);     WAIT_BAR(2); RESC(); ROT();
    STEP(pA0,pA1,pB0,pB1,t+1,true,true,true);   WAIT_BAR(2); RESC(); ROT();
  }
  #undef CMASK
  #define CMASK(P0,P1,t) do{int jb_=(t)-(NT-4); if(jb_>=0)cmask(P0,P1,jb_,qrel,hi);}while(0)
  #define ENDW(tt) do{ if((tt)+3<NT){WAIT_BAR(2);} else if((tt)+2<NT){WAIT_BAR(1);} else {WAIT_BAR(0);} }while(0)
  for(;t+1<NT;t+=2){
    STEP(pB0,pB1,pA0,pA1,t,(t+3<NT),(t+1<NT),(t+1<NT));       ENDW(t);   RESC(); ROT();
    STEP(pA0,pA1,pB0,pB1,t+1,(t+4<NT),(t+2<NT),(t+2<NT));     ENDW(t+1); RESC(); ROT();
  }
  STEP(pB0,pB1,pA0,pA1,NT-1,false,false,false); RESC();
  { float sacc=pB0[0]+pB0[1]; _Pragma("unroll") for(int r=2;r<16;++r)sacc+=pB0[r]; _Pragma("unroll") for(int r=0;r<16;++r)sacc+=pB1[r]; l_reg+=sacc;
    pw0=(u32x4){PKW(pB0,0),PKW(pB0,2),PKW(pB0,4),PKW(pB0,6)};pw1=(u32x4){PKW(pB0,8),PKW(pB0,10),PKW(pB0,12),PKW(pB0,14)};pw2=(u32x4){PKW(pB1,0),PKW(pB1,2),PKW(pB1,4),PKW(pB1,6)};pw3=(u32x4){PKW(pB1,8),PKW(pB1,10),PKW(pB1,12),PKW(pB1,14)};
    int ln_=lane; asm volatile("":"+v"(ln_)); const int vb0=(int)(lds0+LDS_V)+((ln_>>4)&1)*32+(ln_&3)*8+(4*(ln_>>5)+((ln_&15)>>2))*64;
    SBAR(); pv(o,vb0+sl_cur,PAF(0),PAF(1),PAF(2),PAF(3)); }
  #undef PKW
  #undef PAF
  #undef VFR
  #undef PIN
  #undef MX3
  #undef GAPA
  #undef GAPB
  #undef EX
  #undef VRD
  #undef KRD
  #undef STEP
  #undef ENDW
  {auto rr=__builtin_amdgcn_permlane32_swap(__float_as_uint(l_reg),__float_as_uint(l_reg),false,false);l_reg=__uint_as_float(rr[0])+__uint_as_float(rr[1]);}
  if(hi==0)wsf[32+r32]=l_reg;asm volatile("s_waitcnt lgkmcnt(0)":::"memory");
  float rli[16];
  #pragma unroll
  for(int r=0;r<16;++r)rli[r]=__builtin_amdgcn_rcpf(wsf[32+crow(r,hi)]);
  bf16*Ow=O+(rowbase+q0+wid*QBLK)*OP+h*D;
  { bf16*stg=(bf16*)(shm+LDS_OST)+wid*2048;
    #pragma unroll
    for(int r=0;r<16;++r){const int orow=crow(r,hi);
      #pragma unroll
      for(int d0=0;d0<2;++d0)stg[orow*64+d0*32+r32]=__float2bfloat16(o[d0][r]*rli[r]);}
    asm volatile("s_waitcnt lgkmcnt(0)":::"memory");
    #pragma unroll
    for(int i=0;i<4;++i){const int row=i*8+(lane>>3),ch=lane&7; const u32x4 v=*(const u32x4*)(stg+row*64+ch*8); ATTN_STORE16(Ow+(long)row*OP+ch*8,v);} }
  asm volatile("s_waitcnt lgkmcnt(0)\n\ts_barrier":::"memory");
  #undef DMA_K
  #undef DMA_V
  #undef CMASK
  #undef KBIAS
  #undef START
  #undef RESC
  #undef ROT
}
constexpr int ATTN_LDS_BYTES=LDS_BYTES;
#undef SBAR
#undef WAIT_BAR
}

constexpr int NWAVES = 8, NTHR = NWAVES * 64;
constexpr int BATCH = 8, SEQ = 4096, D = 1024, M = BATCH * SEQ;
constexpr int NGRP = 32, NST = 64, SSMW = 512, FOXH = 8;
constexpr int FF = 2816, MEMT = 256, MROWS = BATCH * MEMT;
constexpr int WIN_LD = 2056;
constexpr float RMS_EPS = 1e-6f;
constexpr float LOG2E = 1.4426950408889634f;

constexpr size_t MiB = 1u << 20;
constexpr size_t WS_LOGF = 2 * MiB, WS_FCUM = 3 * MiB;
constexpr size_t WS_WIN = 4 * MiB, WS_WGLU = 8 * MiB, WS_WOUT = 9 * MiB, WS_WQ = 11 * MiB, WS_WKV = 13 * MiB, WS_WO = 17 * MiB, WS_WGU = 19 * MiB, WS_WDN = 30 * MiB;
constexpr size_t WS_W1S = 36 * MiB, WS_W3S = 40 * MiB, WS_MEMN = 46 * MiB, WS_KMEM = 50 * MiB, WS_VT = 54 * MiB;
constexpr size_t WS_H = 64 * MiB, WS_T = 128 * MiB, WS_YMIX = 192 * MiB, WS_QKV = 256 * MiB, WS_UA = 352 * MiB, WS_S = 400 * MiB, WS_G = 432 * MiB, WS_END = 464 * MiB;
constexpr size_t WS_Q2 = WS_YMIX, WS_P = WS_QKV, WS_O2 = WS_UA, WS_ACT = WS_QKV;
static_assert(WS_WGU + (size_t)2 * FF * D * 2 <= WS_WDN && WS_WDN + (size_t)D * FF * 2 <= WS_W1S && WS_W3S + (size_t)NGRP * 256 * 384 * 2 <= WS_MEMN, "ws map");
static_assert(WS_UA + (size_t)NGRP * 2048 * 384 * 2 <= WS_S && WS_S + (size_t)NGRP * 2048 * 128 * 4 <= WS_G && WS_ACT + (size_t)M * FF * 2 <= WS_G + 32 * MiB, "ws map");

constexpr int RING_BYTES = 131072, SCR_OFF = RING_BYTES, MISC_OFF = SCR_OFF + 8192, LDS_BYTES = 147456;
constexpr size_t WS_CTL = 0, CTL_ZERO_BYTES = 65536;
static_assert(attn_body::ATTN_LDS_BYTES <= RING_BYTES, "attention LDS");

typedef unsigned short bf16;
typedef unsigned v4u __attribute__((ext_vector_type(4)));
typedef float f32x4 __attribute__((ext_vector_type(4)));
#define LDS_WAIT() asm volatile("s_waitcnt lgkmcnt(0)" ::: "memory")
__device__ __forceinline__ unsigned f2bf(float f) { unsigned u = __builtin_bit_cast(unsigned, f); return (u + 0x7fffu + ((u >> 16) & 1u)) >> 16; }
__device__ __forceinline__ unsigned pk2(float lo, float hi) { return f2bf(lo) | (f2bf(hi) << 16); }
__device__ __forceinline__ float wave_sum(float v) {
#pragma unroll
    for (int o = 1; o < 64; o <<= 1) v += __shfl_xor(v, o);
    return v;
}


#define XB_TMO      128
#define XB_XCNT(j)  (256  + 64 * (j))
#define XB_XSUB(j)  (1280 + 64 * (j))
#define XB_XGEN(j)  (2304 + 64 * (j))
#define XB_TOP      3328
#define XB_TOPGEN   3392
#define XCD_BAR_WORDS 3456
#define XB_SPIN_CAP (1u << 18)
__device__ __forceinline__ unsigned xb_ld(unsigned* p)              { return __hip_atomic_load(p, __ATOMIC_RELAXED, __HIP_MEMORY_SCOPE_AGENT); }
__device__ __forceinline__ unsigned xb_add(unsigned* p, unsigned v) { return __hip_atomic_fetch_add(p, v, __ATOMIC_RELAXED, __HIP_MEMORY_SCOPE_AGENT); }
__device__ __forceinline__ unsigned xb_xcc_id() { return (unsigned)__builtin_amdgcn_s_getreg((3 << 11) | 20) & 0xFu; }
#define XB_SPIN(cond, bar) do { unsigned _sp = 0; while (cond) { __builtin_amdgcn_s_sleep(1); \
    if ((++_sp & 255u) == 0u) { if (xb_ld(&(bar)[XB_TMO])) break; if (_sp > XB_SPIN_CAP) { atomicAdd(&(bar)[XB_TMO], 1u); break; } } } } while (0)
struct XcdBarrier { unsigned* bar; unsigned x; volatile LAS unsigned* st; };
__device__ __forceinline__ XcdBarrier xcd_barrier_post(unsigned* bar, volatile LAS unsigned* st) {
    XcdBarrier b; b.bar = bar; b.x = xb_xcc_id(); b.st = st;
    if (threadIdx.x == 0) (void)xb_add(&bar[XB_XCNT(b.x)], 1u);
    return b;
}
__device__ __forceinline__ void xcd_barrier_complete(unsigned* bar, unsigned x, unsigned& nloc, unsigned& nx) {
    const unsigned G = gridDim.x * gridDim.y * gridDim.z;
    unsigned sum, cnt, mine, sp = 0u;
    for (;;) {
        sum = 0u; cnt = 0u; mine = 0u;
#pragma unroll
        for (unsigned j = 0; j < 16; ++j) { const unsigned c = xb_ld(&bar[XB_XCNT(j)]); sum += c; cnt += (c > 0u) ? 1u : 0u; mine = (j == x) ? c : mine; }
        if (sum == G) break;
        __builtin_amdgcn_s_sleep(1);
        if ((++sp & 255u) == 0u) { if (xb_ld(&bar[XB_TMO])) break; if (sp > XB_SPIN_CAP) { atomicAdd(&bar[XB_TMO], 1u); break; } }
    }
    nloc = mine > 0u ? mine : 1u; nx = cnt > 0u ? cnt : 1u;
}
__device__ __forceinline__ void xcd_barrier(const XcdBarrier& b) {
    asm volatile("s_waitcnt vmcnt(0)" ::: "memory");
    __syncthreads();
    if (threadIdx.x == 0) {
        unsigned* bar = b.bar;
        __builtin_amdgcn_s_waitcnt(0);
        unsigned nloc = b.st[0], nx = b.st[1];
        if (nloc == 0u) { xcd_barrier_complete(bar, b.x, nloc, nx); b.st[0] = nloc; b.st[1] = nx; }
        const unsigned old = xb_add(&bar[XB_XSUB(b.x)], 1u);
        const unsigned gen = old / nloc;
        if (old + 1u == (gen + 1u) * nloc) {
            __builtin_amdgcn_fence(__ATOMIC_RELEASE, "agent");
            asm volatile("s_waitcnt vmcnt(0)" ::: "memory");
            const unsigned og = xb_add(&bar[XB_TOP], 1u);
            const unsigned tg = og / nx;
            if (og + 1u == (tg + 1u) * nx) xb_add(&bar[XB_TOPGEN], 1u);
            else XB_SPIN(xb_ld(&bar[XB_TOPGEN]) == tg, bar);
            __builtin_amdgcn_fence(__ATOMIC_ACQUIRE, "agent");
            xb_add(&bar[XB_XGEN(b.x)], 1u);
            asm volatile("s_waitcnt vmcnt(0)" ::: "memory");
        } else {
            XB_SPIN(xb_ld(&bar[XB_XGEN(b.x)]) == gen, bar);
            __builtin_amdgcn_fence(__ATOMIC_ACQUIRE, "agent");
            asm volatile("s_waitcnt vmcnt(0)" ::: "memory");
        }
    }
    __syncthreads();
}
__device__ __forceinline__ int fresh_tid() { int t = threadIdx.x; asm volatile("" : "+v"(t)); return t; }
struct Args { const float* in[30]; float* out; unsigned char* ws; int ph_lo, ph_hi; };
typedef const __attribute__((address_space(4))) Args* KArgs;
struct Frame {
    LAS unsigned char* lds;
    int wave, vcu, G;
    KArgs kap; float* out; unsigned char* ws;
    __device__ __forceinline__ const float* inp(int i) const { KArgs p = kap; asm volatile("" : "+s"(p)); return p->in[i]; }
};

__device__ __forceinline__ void transpose_item(const float* W, int ldw, int col0, int k0, bf16* WT, int Kp, int drow, LAS float* scr, int lane) {
#pragma unroll 8
    for (int i = 0; i < 32; ++i) { const int kk = 2 * i + (lane >> 5); scr[kk * 33 + (lane & 31)] = W[(size_t)(k0 + kk) * ldw + col0 + (lane & 31)]; }
    LDS_WAIT(); asm volatile("" ::: "memory");
    const int c = lane & 7;
#pragma unroll
    for (int j = 0; j < 4; ++j) { const int n = (lane >> 3) + 8 * j; const LAS float* s = scr + (8 * c) * 33 + n;
        v4u o; o.x = pk2(s[0 * 33], s[1 * 33]); o.y = pk2(s[2 * 33], s[3 * 33]); o.z = pk2(s[4 * 33], s[5 * 33]); o.w = pk2(s[6 * 33], s[7 * 33]);
        *(v4u*)(WT + (size_t)(drow + n) * Kp + k0 + 8 * c) = o; }
    LDS_WAIT(); asm volatile("" ::: "memory");
}
__device__ __forceinline__ void cpow(float are, float aim, float dt, float tau, float& pr, float& pi) {
    const float mag = __builtin_amdgcn_exp2f(are * dt * tau * LOG2E);
    float rev = aim * dt * tau * 0.15915494309189535f; rev -= __builtin_rintf(rev);
    pr = mag * __builtin_amdgcn_cosf(rev); pi = mag * __builtin_amdgcn_sinf(rev);
}
__device__ __forceinline__ void zoh_coef(float are, float aim, float dt, float& cr, float& ci) {
    float br, bi; cpow(are, aim, dt, 1.0f, br, bi); const float nr = br - 1.0f, ni = bi, den = 1.0f / (are * are + aim * aim);
    cr = (nr * are + ni * aim) * den; ci = (ni * are - nr * aim) * den;
}
__device__ __forceinline__ void store16bf(bf16* dst, const float (&v)[16]) {
    v4u a, b; a.x = pk2(v[0], v[1]); a.y = pk2(v[2], v[3]); a.z = pk2(v[4], v[5]); a.w = pk2(v[6], v[7]); b.x = pk2(v[8], v[9]); b.y = pk2(v[10], v[11]); b.z = pk2(v[12], v[13]); b.w = pk2(v[14], v[15]);
    *(v4u*)dst = a; *(v4u*)(dst + 8) = b;
}
__device__ __forceinline__ void p0_ssm_tables(Frame& F) {
    const float* a_re = F.inp(4); const float* a_im = F.inp(5); const float* log_dt = F.inp(6); const float* b_re = F.inp(7); const float* b_im = F.inp(8);
    const float* c_re = F.inp(9); const float* c_im = F.inp(10); const float* dsk = F.inp(11);
    bf16* W1S = (bf16*)(F.ws + WS_W1S); bf16* W3S = (bf16*)(F.ws + WS_W3S);
    const int gt = F.vcu * NTHR + fresh_tid(), NT_ = F.G * NTHR;
    constexpr int NA = NGRP * 16 * 16 * 16, NB = NGRP * 16 * 16 * 64, NC = NGRP * 64 * 16;
    for (int it = gt; it < NA + NB + NC; it += NT_) {
        if (it < NA) {
            const int i = it & 15, o = (it >> 4) & 15, j = (it >> 8) & 15, g = it >> 12;
            float acc[16];
#pragma unroll
            for (int c = 0; c < 16; ++c) acc[c] = 0.f;
            if (i <= j) {
                const float dt = __expf(log_dt[g]), tau = (float)(j - i);
                for (int n = 0; n < NST; ++n) {
                    const float are = a_re[g * NST + n], aim = a_im[g * NST + n];
                    float pr, pi, cr, ci; cpow(are, aim, dt, tau, pr, pi); zoh_coef(are, aim, dt, cr, ci);
                    const float wr_ = pr * cr - pi * ci, wi_ = pr * ci + pi * cr;
                    const float Cr = c_re[(g * 16 + o) * NST + n], Ci = c_im[(g * 16 + o) * NST + n];
                    const float qr = Cr * wr_ - Ci * wi_, qi = Cr * wi_ + Ci * wr_;
                    const f32x4* br = (const f32x4*)(b_re + (size_t)(g * NST + n) * 16); const f32x4* bi = (const f32x4*)(b_im + (size_t)(g * NST + n) * 16);
#pragma unroll
                    for (int c4 = 0; c4 < 4; ++c4) { const f32x4 x = br[c4], y = bi[c4];
#pragma unroll
                        for (int e = 0; e < 4; ++e) acc[4 * c4 + e] += qr * x[e] - qi * y[e]; }
                }
                if (i == j) { const float dv = dsk[g * 16 + o];
#pragma unroll
                    for (int c = 0; c < 16; ++c) acc[c] += (c == o) ? dv : 0.f; }
            }
            store16bf(W3S + ((size_t)(g * 256 + j * 16 + o) * 384 + i * 16), acc);
        } else if (it < NA + NB) {
            const int r = it - NA, n = r & 63, o = (r >> 6) & 15, j = (r >> 10) & 15, g = r >> 14;
            const float dt = __expf(log_dt[g]); float pr, pi; cpow(a_re[g * NST + n], a_im[g * NST + n], dt, (float)(j + 1), pr, pi);
            const float Cr = c_re[(g * 16 + o) * NST + n], Ci = c_im[(g * 16 + o) * NST + n];
            bf16* row = W3S + (size_t)(g * 256 + j * 16 + o) * 384;
            row[256 + n] = (bf16)f2bf(Cr * pr - Ci * pi); row[320 + n] = (bf16)f2bf(-(Cr * pi + Ci * pr));
        } else {
            const int r = it - NA - NB, i = r & 15, n = (r >> 4) & 63, g = r >> 10;
            const float dt = __expf(log_dt[g]), are = a_re[g * NST + n], aim = a_im[g * NST + n];
            float pr, pi, cr, ci; cpow(are, aim, dt, (float)(15 - i), pr, pi); zoh_coef(are, aim, dt, cr, ci);
            const float wr_ = pr * cr - pi * ci, wi_ = pr * ci + pi * cr;
            float vr[16], vi[16];
            const f32x4* br = (const f32x4*)(b_re + (size_t)(g * NST + n) * 16); const f32x4* bi = (const f32x4*)(b_im + (size_t)(g * NST + n) * 16);
#pragma unroll
            for (int c4 = 0; c4 < 4; ++c4) { const f32x4 x = br[c4], y = bi[c4];
#pragma unroll
                for (int e = 0; e < 4; ++e) { vr[4 * c4 + e] = wr_ * x[e] - wi_ * y[e]; vi[4 * c4 + e] = wr_ * y[e] + wi_ * x[e]; } }
            store16bf(W1S + ((size_t)(g * 256 + n) * 256 + i * 16), vr);
            store16bf(W1S + ((size_t)(g * 256 + 64 + n) * 256 + i * 16), vi);
        }
    }
}
__device__ __forceinline__ void rms_row_to_bf16(const float* xrow, const float* gain, bf16* orow, int lane, f32x4 (&v)[4], float& rstd) {
    const f32x4* xr = (const f32x4*)xrow + lane; float s = 0.f;
#pragma unroll
    for (int j = 0; j < 4; ++j) { v[j] = xr[64 * j]; s += (v[j].x * v[j].x + v[j].y * v[j].y) + (v[j].z * v[j].z + v[j].w * v[j].w); }
    rstd = 1.0f / sqrtf(wave_sum(s) * (1.f / D) + RMS_EPS);
    unsigned long long* o8 = (unsigned long long*)orow + lane;
#pragma unroll
    for (int j = 0; j < 4; ++j) { const f32x4 gv = ((const f32x4*)gain)[64 * j + lane]; v[j] = v[j] * rstd * gv;
        o8[64 * j] = (unsigned long long)pk2(v[j].x, v[j].y) | ((unsigned long long)pk2(v[j].z, v[j].w) << 32); }
}
__device__ __forceinline__ void p0_prologue(Frame& F) {
    const int tid_ = fresh_tid(), lane_ = tid_ & 63;
    LAS float* scr = (LAS float*)(F.lds + F.wave * 16384);
    const int gw = F.vcu * NWAVES + F.wave, NGW = F.G * NWAVES;
    bf16* ws16 = (bf16*)F.ws;
    constexpr int I_IN = 16 * 64, I_GLU = 8 * 16, I_SQ = 16 * 32, I_KV = 16 * 64, I_GU = 16 * 88, I_DN = 44 * 32;
    constexpr int NITEMS = I_IN + I_GLU + 3 * I_SQ + I_KV + 2 * I_GU + I_DN;
    for (int it = gw; it < NITEMS; it += NGW) {
        int r = it;
        if (r < I_IN) { transpose_item(F.inp(3), WIN_LD, 32 * (r % 64), 64 * (r / 64), (bf16*)(F.ws + WS_WIN), 1024, 32 * (r % 64), scr, lane_); continue; } r -= I_IN;
        if (r < I_GLU) { transpose_item(F.inp(12), 512, 32 * (r % 16), 64 * (r / 16), (bf16*)(F.ws + WS_WGLU), 512, 32 * (r % 16), scr, lane_); continue; } r -= I_GLU;
        if (r < I_SQ) { transpose_item(F.inp(17), 1024, 32 * (r % 32), 64 * (r / 32), (bf16*)(F.ws + WS_WOUT), 1024, 32 * (r % 32), scr, lane_); continue; } r -= I_SQ;
        if (r < I_SQ) { transpose_item(F.inp(21), 1024, 32 * (r % 32), 64 * (r / 32), (bf16*)(F.ws + WS_WQ), 1024, 32 * (r % 32), scr, lane_); continue; } r -= I_SQ;
        if (r < I_KV) { transpose_item(F.inp(22), 2048, 32 * (r % 64), 64 * (r / 64), (bf16*)(F.ws + WS_WKV), 1024, 32 * (r % 64), scr, lane_); continue; } r -= I_KV;
        if (r < I_SQ) { transpose_item(F.inp(23), 1024, 32 * (r % 32), 64 * (r / 32), (bf16*)(F.ws + WS_WO), 1024, 32 * (r % 32), scr, lane_); continue; } r -= I_SQ;
        if (r < I_GU) { const int n0 = 32 * (r % 88); transpose_item(F.inp(26), FF, n0, 64 * (r / 88), (bf16*)(F.ws + WS_WGU), 1024, (n0 / 128) * 256 + (n0 % 128), scr, lane_); continue; } r -= I_GU;
        if (r < I_GU) { const int n0 = 32 * (r % 88); transpose_item(F.inp(27), FF, n0, 64 * (r / 88), (bf16*)(F.ws + WS_WGU), 1024, (n0 / 128) * 256 + 128 + (n0 % 128), scr, lane_); continue; } r -= I_GU;
        transpose_item(F.inp(28), 1024, 32 * (r % 32), 64 * (r / 32), (bf16*)(F.ws + WS_WDN), FF, 32 * (r % 32), scr, lane_);
    }
    (void)ws16;
    p0_ssm_tables(F);
    __syncthreads();
    LAS float* wf = (LAS float*)F.lds;
    { const float* w_in = F.inp(3); for (int i = tid_; i < D * 8; i += NTHR) wf[i] = w_in[(size_t)(i >> 3) * WIN_LD + 2048 + (i & 7)]; }
    const float* xin_ = F.inp(0); const float* g_pre = F.inp(2); const float* fbias = F.inp(14);
    __syncthreads();
    float* LOGF = (float*)(F.ws + WS_LOGF);
    for (int m = gw; m < M; m += NGW) {
        f32x4 v[4]; float rstd; rms_row_to_bf16(xin_ + (size_t)m * D, g_pre, (bf16*)(F.ws + WS_H) + (size_t)m * D, lane_, v, rstd);
        float fs[8];
#pragma unroll
        for (int h = 0; h < 8; ++h) fs[h] = 0.f;
#pragma unroll
        for (int j = 0; j < 4; ++j)
#pragma unroll
            for (int e = 0; e < 4; ++e) { const int k = 256 * j + 4 * lane_ + e; const f32x4 w0 = *(const LAS f32x4*)(wf + k * 8), w1 = *(const LAS f32x4*)(wf + k * 8 + 4); const float hv = v[j][e];
                fs[0] += hv * w0[0]; fs[1] += hv * w0[1]; fs[2] += hv * w0[2]; fs[3] += hv * w0[3]; fs[4] += hv * w1[0]; fs[5] += hv * w1[1]; fs[6] += hv * w1[2]; fs[7] += hv * w1[3]; }
#pragma unroll
        for (int h = 0; h < 8; ++h) fs[h] = wave_sum(fs[h]);
        if (lane_ < 8) { const int h = lane_;
            float z = (h == 0) ? fs[0] : (h == 1) ? fs[1] : (h == 2) ? fs[2] : (h == 3) ? fs[3] : (h == 4) ? fs[4] : (h == 5) ? fs[5] : (h == 6) ? fs[6] : fs[7];
            z += fbias[h];
            const float ls = fminf(z, 0.f) - log1pf(__expf(-fabsf(z)));
            LOGF[(size_t)((m >> 12) * FOXH + h) * SEQ + (m & 4095)] = ls; }
    }
    const float* mem_ = F.inp(1); const float* memg = F.inp(20);
    for (int m = gw; m < MROWS; m += NGW) { f32x4 v[4]; float rstd; rms_row_to_bf16(mem_ + (size_t)m * D, memg, (bf16*)(F.ws + WS_MEMN) + (size_t)m * D, lane_, v, rstd); }
}
__device__ __forceinline__ void cumsum_phase(Frame& F) {
    const int tid_ = fresh_tid(), lane_ = tid_ & 63;
    LAS float* wtot = (LAS float*)(F.lds + SCR_OFF);
    const float* LOGF = (const float*)(F.ws + WS_LOGF); float* FCUM = (float*)(F.ws + WS_FCUM);
    for (int seq = F.vcu; seq < BATCH * FOXH; seq += F.G) {
        const f32x4* src = (const f32x4*)(LOGF + (size_t)seq * SEQ + 8 * tid_); f32x4 a = src[0], b = src[1];
        a[1] += a[0]; a[2] += a[1]; a[3] += a[2]; b[0] += a[3]; b[1] += b[0]; b[2] += b[1]; b[3] += b[2];
        float inc = b[3];
#pragma unroll
        for (int o = 1; o < 64; o <<= 1) { const float nb = __shfl_up(inc, o); if (lane_ >= o) inc += nb; }
        if (lane_ == 63) wtot[F.wave] = inc;
        __syncthreads();
        float base = inc - b[3];
        for (int w = 0; w < F.wave; ++w) base += wtot[w];
        f32x4* dst = (f32x4*)(FCUM + (size_t)seq * SEQ + 8 * tid_);
        dst[0] = (a + base) * LOG2E; dst[1] = (b + base) * LOG2E;
        __syncthreads();
    }
}
__device__ __forceinline__ void ssm_scan_item(Frame& F, int g, int b) {
    const int n = fresh_tid() & 63;
    const float dt = __expf(F.inp(6)[g]); float Ar, Ai; cpow(F.inp(4)[g * NST + n], F.inp(5)[g * NST + n], dt, 16.0f, Ar, Ai);
    const float* S = (const float*)(F.ws + WS_S) + (size_t)(g * 2048 + b * 256) * 128; bf16* UA = (bf16*)(F.ws + WS_UA) + (size_t)(g * 2048 + b * 256) * 384;
    float hr = 0.f, hi = 0.f;
#pragma unroll 8
    for (int k = 0; k < 256; ++k) {
        const float sr = S[k * 128 + n], si = S[k * 128 + 64 + n];
        UA[k * 384 + 256 + n] = (bf16)f2bf(hr); UA[k * 384 + 320 + n] = (bf16)f2bf(hi);
        const float nr = Ar * hr - Ai * hi + sr, ni = Ar * hi + Ai * hr + si; hr = nr; hi = ni;
    }
}
__device__ __forceinline__ void rowpass_mix(Frame& F) {
    const int lane_ = fresh_tid() & 63;
    const int gw = F.vcu * NWAVES + F.wave, NGW = F.G * NWAVES; const float* g1 = F.inp(15); const float* g2 = F.inp(16);
    for (int m = gw; m < M; m += NGW) {
        v4u* row = (v4u*)((bf16*)(F.ws + WS_YMIX) + (size_t)m * D);
#pragma unroll
        for (int hf = 0; hf < 2; ++hf) { const v4u w = row[hf * 64 + lane_]; float x[8];
            x[0] = pg8::bf_lo(w.x); x[1] = pg8::bf_hi(w.x); x[2] = pg8::bf_lo(w.y); x[3] = pg8::bf_hi(w.y); x[4] = pg8::bf_lo(w.z); x[5] = pg8::bf_hi(w.z); x[6] = pg8::bf_lo(w.w); x[7] = pg8::bf_hi(w.w);
            float s = 0.f;
#pragma unroll
            for (int e = 0; e < 8; ++e) s += x[e] * x[e];
            const float rstd = 1.0f / sqrtf(wave_sum(s) * (1.f / 512.f) + RMS_EPS);
            const float* gp = (hf ? g2 : g1) + 8 * lane_; const f32x4 ga = *(const f32x4*)gp, gb = *(const f32x4*)(gp + 4);
            v4u o; o.x = pk2(x[0] * rstd * ga[0], x[1] * rstd * ga[1]); o.y = pk2(x[2] * rstd * ga[2], x[3] * rstd * ga[3]); o.z = pk2(x[4] * rstd * gb[0], x[5] * rstd * gb[1]); o.w = pk2(x[6] * rstd * gb[2], x[7] * rstd * gb[3]);
            row[hf * 64 + lane_] = o; }
    }
}
__device__ __forceinline__ void rowpass_res(Frame& F, const float* xin, float* xo, const float* gpost, const float* gpre) {
    const int lane_ = fresh_tid() & 63;
    const int gw = F.vcu * NWAVES + F.wave, NGW = F.G * NWAVES;
    for (int m = gw; m < M; m += NGW) {
        const unsigned long long* tr = (const unsigned long long*)((const bf16*)(F.ws + WS_T) + (size_t)m * D) + lane_;
        const f32x4* xr = (const f32x4*)(xin + (size_t)m * D) + lane_;
        f32x4 t[4], x[4]; float s = 0.f;
#pragma unroll
        for (int j = 0; j < 4; ++j) { const unsigned long long w = tr[64 * j]; x[j] = xr[64 * j];
            t[j] = (f32x4){pg8::bf_lo((unsigned)w), pg8::bf_hi((unsigned)w), pg8::bf_lo((unsigned)(w >> 32)), pg8::bf_hi((unsigned)(w >> 32))};
            s += (t[j].x * t[j].x + t[j].y * t[j].y) + (t[j].z * t[j].z + t[j].w * t[j].w); }
        const float rstd = 1.0f / sqrtf(wave_sum(s) * (1.f / D) + RMS_EPS); float s2 = 0.f;
        f32x4* orow = (f32x4*)(xo + (size_t)m * D) + lane_;
#pragma unroll
        for (int j = 0; j < 4; ++j) { const f32x4 gv = ((const f32x4*)gpost)[64 * j + lane_]; x[j] = x[j] + t[j] * rstd * gv; orow[64 * j] = x[j];
            s2 += (x[j].x * x[j].x + x[j].y * x[j].y) + (x[j].z * x[j].z + x[j].w * x[j].w); }
        if (gpre) { const float r2 = 1.0f / sqrtf(wave_sum(s2) * (1.f / D) + RMS_EPS);
            unsigned long long* o8 = (unsigned long long*)((bf16*)(F.ws + WS_H) + (size_t)m * D) + lane_;
#pragma unroll
            for (int j = 0; j < 4; ++j) { const f32x4 gv = ((const f32x4*)gpre)[64 * j + lane_]; const f32x4 hv = x[j] * r2 * gv;
                o8[64 * j] = (unsigned long long)pk2(hv.x, hv.y) | ((unsigned long long)pk2(hv.z, hv.w) << 32); } }
    }
}

constexpr int N_PHASES = 16;
__global__ void __launch_bounds__(NTHR, 2) mk_fwd(Args args) {
    __builtin_assume(__builtin_amdgcn_workitem_id_y() == 0); __builtin_assume(__builtin_amdgcn_workitem_id_z() == 0);
    extern __shared__ __attribute__((aligned(16))) unsigned char lds[];
    Frame F;
    F.lds = (LAS unsigned char*)lds;
    F.wave = __builtin_amdgcn_readfirstlane((int)threadIdx.x >> 6);
    F.G = gridDim.x; { const int bx = blockIdx.x; F.vcu = (F.G % 8 == 0) ? (bx % 8) * (F.G / 8) + bx / 8 : bx; }
    F.kap = (KArgs)__builtin_amdgcn_kernarg_segment_ptr();
    F.out = args.out; F.ws = args.ws;
    LAS unsigned char* ring = F.lds; LAS unsigned char* scr = F.lds + SCR_OFF;
    volatile LAS unsigned* MISC = (volatile LAS unsigned*)(F.lds + MISC_OFF);
    if (threadIdx.x < 32) MISC[threadIdx.x] = 0u;
    __syncthreads();
    XcdBarrier bar = xcd_barrier_post((unsigned*)(args.ws + WS_CTL), MISC + 8);
    if (args.ph_lo < 0) cg::this_grid().sync();
    const int lo = args.ph_lo, hi = args.ph_hi, bx = (int)blockIdx.x, G = F.G;
#ifndef ONLY_PHASE
#define ONLY_PHASE -1
#endif
#define IN(k) ((ONLY_PHASE < 0 || ONLY_PHASE == (k)) && lo <= (k) && (k) < hi)
#define SEAM(k) do { if (IN(k) && IN((k) + 1)) for (int s_ = 0; s_ < DUP_SEAM; ++s_) xcd_barrier(bar); } while (0)
#define REP(k) for (int rep_ = 0; rep_ < ((DUP_PHASE == (k)) ? 2 : 1); ++rep_)
    using namespace pg8;
    const char* wsc = (const char*)F.ws;

    if (IN(0)) REP(0) { p0_prologue(F); } SEAM(0);

    if (IN(1)) REP(1) {
        Gemm g{1024, 1024, 1024}; Sched<MODE_MN> S{128 * 8, G, bx, 128, 8, wsc + WS_H, wsc + WS_WIN, (size_t)256 * 1024 * 2, (size_t)256 * 1024 * 2};
        EpiInProj E{(bf16_t*)(F.ws + WS_UA), (bf16_t*)(F.ws + WS_QKV), attn_body::C2};
        gemm_phase<EpiInProj, Sched<MODE_MN>, true>(ring, g, S, E, scr);
    } SEAM(1);

    if (IN(2)) REP(2) {
        cumsum_phase(F);
        { Gemm g{384, 256, 256}; Sched<MODE_SSM> S{256, G, bx, 0, 0, wsc + WS_UA, wsc + WS_W1S, 0, (size_t)256 * 256 * 2};
          EpiS1 E{(float*)(F.ws + WS_S)}; gemm_phase<EpiS1, Sched<MODE_SSM>, true>(ring, g, S, E, scr); }
        { Gemm g{1024, 1024, 1024}; Sched<MODE_MN> S{8 * 4, G, bx, 8, 4, wsc + WS_MEMN, wsc + WS_WKV, (size_t)256 * 1024 * 2, (size_t)256 * 1024 * 2};
          EpiPlain E{(bf16_t*)(F.ws + WS_KMEM), 1024}; gemm_phase<EpiPlain, Sched<MODE_MN>, true>(ring, g, S, E, scr); }
        { Gemm g{1024, 1024, 1024}; Sched<MODE_MN> S{4 * 8, G, (bx + G - 32) % G, 4, 8, wsc + WS_WKV + (size_t)1024 * 1024 * 2, wsc + WS_MEMN, (size_t)256 * 1024 * 2, (size_t)256 * 1024 * 2};
          EpiPlain E{(bf16_t*)(F.ws + WS_VT), 2048}; gemm_phase<EpiPlain, Sched<MODE_MN>, true>(ring, g, S, E, scr); }
    } SEAM(2);

    if (IN(3)) REP(3) {
        const attn_body::bf16* QKV = (const attn_body::bf16*)(F.ws + WS_QKV);
        for (int quad = F.vcu; quad < 256; quad += G) {
            const int bh = quad >> 2, s = quad & 3;
#pragma unroll 1
            for (int i = 0; i < 4; ++i) { const int qb = (i == 0) ? s : (i == 1) ? 7 - s : (i == 2) ? 8 + s : 15 - s;
                attn_body::attn_unit<8>(bh >> 3, bh & 7, qb, QKV, QKV + 512, QKV + 1024, (attn_body::bf16*)(F.ws + WS_YMIX) + 512, (const float*)(F.ws + WS_FCUM), (char*)lds); }
        }
    }

    if (IN(4)) REP(4) {
        __syncthreads();
        if (F.wave == 0) for (int L = bx; L < 256; L += G) ssm_scan_item(F, L >> 3, L & 7);
        __threadfence(); __syncthreads();
        Gemm g{384, 384, 384}; Sched<MODE_SSM> S{256, G, bx, 0, 0, wsc + WS_UA, wsc + WS_W3S, 0, (size_t)256 * 384 * 2};
        EpiS3 E{(bf16_t*)(F.ws + WS_G)}; gemm_phase<EpiS3, Sched<MODE_SSM>, true>(ring, g, S, E, scr);
    } SEAM(4);

    if (IN(5)) REP(5) {
        Gemm g{512, 512, 512}; Sched<MODE_MN> S{128 * 2, G, bx, 128, 2, wsc + WS_G, wsc + WS_WGLU, (size_t)256 * 512 * 2, (size_t)256 * 512 * 2};
        EpiGlu E{(const bf16_t*)(F.ws + WS_G), F.inp(13), (bf16_t*)(F.ws + WS_YMIX)}; gemm_phase<EpiGlu, Sched<MODE_MN>, true>(ring, g, S, E, scr);
    } SEAM(5);

    if (IN(6)) REP(6) { rowpass_mix(F); } SEAM(6);

    if (IN(7)) REP(7) {
        Gemm g{1024, 1024, 1024}; Sched<MODE_MN> S{128 * 4, G, bx, 128, 4, wsc + WS_YMIX, wsc + WS_WOUT, (size_t)256 * 1024 * 2, (size_t)256 * 1024 * 2};
        EpiPlain E{(bf16_t*)(F.ws + WS_T), 1024}; gemm_phase<EpiPlain, Sched<MODE_MN>, true>(ring, g, S, E, scr);
    } SEAM(7);

    if (IN(8)) REP(8) { rowpass_res(F, F.inp(0), F.out, F.inp(18), F.inp(19)); } SEAM(8);

    if (IN(9)) REP(9) {
        Gemm g{1024, 1024, 1024}; Sched<MODE_MN> S{128 * 4, G, bx, 128, 4, wsc + WS_H, wsc + WS_WQ, (size_t)256 * 1024 * 2, (size_t)256 * 1024 * 2};
        EpiPlain E{(bf16_t*)(F.ws + WS_Q2), 1024}; gemm_phase<EpiPlain, Sched<MODE_MN>, true>(ring, g, S, E, scr);
    } SEAM(9);

    if (IN(10)) REP(10) {
        Gemm g{1024, 1024, 256}; Sched<MODE_XS> S{128 * 4, G, bx, 0, 0, wsc + WS_Q2, wsc + WS_KMEM, 0, 0};
        EpiSoftmax E{(bf16_t*)(F.ws + WS_P), 1024, 0.0625f * LOG2E}; gemm_phase<EpiSoftmax, Sched<MODE_XS>, true>(ring, g, S, E, scr);
    } SEAM(10);

    if (IN(11)) REP(11) {
        Gemm g{1024, 2048, 256}; Sched<MODE_XPV> S{128 * 4, G, bx, 0, 0, wsc + WS_P, wsc + WS_VT, 0, 0};
        EpiPlain E{(bf16_t*)(F.ws + WS_O2), 1024}; gemm_phase<EpiPlain, Sched<MODE_XPV>, true>(ring, g, S, E, scr);
    } SEAM(11);

    if (IN(12)) REP(12) {
        Gemm g{1024, 1024, 1024}; Sched<MODE_MN> S{128 * 4, G, bx, 128, 4, wsc + WS_O2, wsc + WS_WO, (size_t)256 * 1024 * 2, (size_t)256 * 1024 * 2};
        EpiPlain E{(bf16_t*)(F.ws + WS_T), 1024}; gemm_phase<EpiPlain, Sched<MODE_MN>, true>(ring, g, S, E, scr);
    } SEAM(12);

    if (IN(13)) REP(13) { rowpass_res(F, F.out, F.out, F.inp(24), F.inp(25)); } SEAM(13);

    if (IN(14)) REP(14) {
        Gemm g{1024, 1024, 1024}; Sched<MODE_MN> S{128 * 22, G, bx, 128, 22, wsc + WS_H, wsc + WS_WGU, (size_t)256 * 1024 * 2, (size_t)256 * 1024 * 2};
        EpiSwiglu E{(bf16_t*)(F.ws + WS_ACT), FF}; gemm_phase<EpiSwiglu, Sched<MODE_MN>, true>(ring, g, S, E, scr);
    } SEAM(14);

    if (IN(15)) REP(15) {
        Gemm g{FF, FF, FF}; Sched<MODE_MN> S{128 * 4, G, bx, 128, 4, wsc + WS_ACT, wsc + WS_WDN, (size_t)256 * FF * 2, (size_t)256 * FF * 2};
        EpiPlain E{(bf16_t*)(F.ws + WS_T), 1024}; gemm_phase<EpiPlain, Sched<MODE_MN>, true>(ring, g, S, E, scr);
    } SEAM(15);
    if (IN(16)) REP(16) { rowpass_res(F, F.out, F.out, F.inp(29), nullptr); }
#undef IN
#undef SEAM
}

extern "C" void kernel_launch(void* const* d_in, const int* in_sizes, int n_in, void* d_out, int out_size, void* d_ws, size_t ws_size, hipStream_t stream) {
    static int grid = 0;
    if (grid == 0) {
        if (n_in != 30 || in_sizes[0] != M * D || out_size != M * D || ws_size < WS_END) { fprintf(stderr, "kernel_launch: unexpected shapes (n_in %d, in0 %d, out %d, ws %zu)\n", n_in, n_in > 0 ? in_sizes[0] : -1, out_size, ws_size); grid = -1; return; }
        int dev = 0, cus = 0, per_cu = 0;
        if (hipGetDevice(&dev) != hipSuccess || hipDeviceGetAttribute(&cus, hipDeviceAttributeMultiprocessorCount, dev) != hipSuccess) { grid = -1; return; }
        if (hipFuncSetAttribute((const void*)mk_fwd, hipFuncAttributeMaxDynamicSharedMemorySize, LDS_BYTES) != hipSuccess) { fprintf(stderr, "kernel_launch: hipFuncSetAttribute failed\n"); grid = -1; return; }
        if (hipOccupancyMaxActiveBlocksPerMultiprocessor(&per_cu, (const void*)mk_fwd, NTHR, LDS_BYTES) != hipSuccess || per_cu < 1) { fprintf(stderr, "kernel_launch: occupancy query says %d\n", per_cu); per_cu = 1; }
        (void)hipGetLastError();
        grid = cus;
    }
    if (grid < 0) return;
    if (hipMemsetAsync((char*)d_ws + WS_CTL, 0, CTL_ZERO_BYTES, stream) != hipSuccess) { fprintf(stderr, "kernel_launch: memset of the barrier words failed\n"); return; }
    Args a{};
    for (int i = 0; i < 30; ++i) a.in[i] = (const float*)d_in[i];
    a.out = (float*)d_out; a.ws = (unsigned char*)d_ws;
#if MK_COOP
    a.ph_lo = 0; a.ph_hi = N_PHASES + 1;
    void* kargs[] = {&a};
    const hipError_t le = hipLaunchCooperativeKernel((const void*)mk_fwd, dim3(grid), dim3(NTHR), kargs, LDS_BYTES, stream);
    if (le != hipSuccess) fprintf(stderr, "kernel_launch: cooperative launch failed: %s (grid %d)\n", hipGetErrorName(le), grid);
#else
    const int cuts[] = {0, 1, 2, 3, 5, 6, 7, 8, 9, 10, 11, 12, 13, 14, 15, 16, 17};
    for (int li = 0; li + 1 < (int)(sizeof(cuts) / sizeof(int)); ++li) {
        a.ph_lo = cuts[li]; a.ph_hi = cuts[li + 1];
        hipLaunchKernelGGL(mk_fwd, dim3(grid), dim3(NTHR), LDS_BYTES, stream, a);
    }
#endif
}
```
